# Optimizing an MI355X kernel written in HIP

```python
import jax, jax.numpy as jnp
from jax import lax
import numpy as np

D_MODEL = 1024
BATCH = 8
SEQ = 4096
DEPTH = 2

CHUNK = 64
RET_HEADS = 4
RET_HEAD_DIM = 128
RET_WIDTH = RET_HEADS * RET_HEAD_DIM
RWKV_HEADS = 8
RWKV_HEAD_DIM = 64
RWKV_WIDTH = RWKV_HEADS * RWKV_HEAD_DIM
DECAY_LORA = 64
AAA_LORA = 64
MV_LORA = 32
GATE_LORA = 160
D_FF = 2816
CONV_WIDTH = 3
ROPE_BASE = 10000.0
LN_EPS = 1e-5
RET_NORM_EPS = 1e-6
LNX_EPS = 64e-5
DEEPNORM_ALPHA = (2 * DEPTH) ** 0.25
DEEPNORM_BETA = (8 * DEPTH) ** -0.25
RWKV_SHIFT_WIDTH = 3 * RWKV_WIDTH + DECAY_LORA + AAA_LORA + GATE_LORA
IN_WIDTH = 4 * RET_WIDTH + RWKV_SHIFT_WIDTH + 2 * D_MODEL

kernel_name = 'hybrid_retention_rwkv7_deepnorm'


def _split(t, sizes):
    out, o = [], 0
    for s in sizes:
        out.append(t[..., o:o + s])
        o += s
    return out


def _layer_norm(x, g, b):
    xf = x.astype(jnp.float32)
    xc = xf - jnp.mean(xf, -1, keepdims=True)
    var = jnp.mean(xc * xc, -1, keepdims=True)
    return xc * lax.rsqrt(var + LN_EPS) * g.astype(jnp.float32) + b.astype(jnp.float32)


def _token_shift(z, mu):
    z_prev = jnp.pad(z[:, :-1], ((0, 0), (1, 0), (0, 0)))
    return z + mu * (z_prev - z)


def _rotary(t, pos):
    half = t.shape[-1] // 2
    inv_freq = ROPE_BASE ** (-jnp.arange(half, dtype=jnp.float32) / half)
    ang = pos[:, None] * inv_freq[None, :]
    cos = jnp.cos(ang)[None, :, None, :]
    sin = jnp.sin(ang)[None, :, None, :]
    t1, t2 = t[..., :half], t[..., half:]
    return jnp.concatenate([t1 * cos - t2 * sin, t1 * sin + t2 * cos], -1)


def _retention_core(q, k, v):
    B, S, H, Dh = q.shape
    N = S // CHUNK
    log_g = jnp.log(1.0 - 2.0 ** (-5.0 - jnp.arange(H, dtype=jnp.float32)))
    idx = jnp.arange(CHUNK, dtype=jnp.float32)
    intra_decay = jnp.exp(log_g[:, None, None] * jnp.abs(idx[:, None] - idx[None, :]))
    q_decay = jnp.exp(log_g[None, :] * (idx[:, None] + 1.0))
    k_decay = jnp.exp(log_g[None, :] * (CHUNK - 1.0 - idx[:, None]))
    chunk_decay = jnp.exp(log_g * CHUNK)
    qc = q.reshape(B, N, CHUNK, H, Dh)
    kc = k.reshape(B, N, CHUNK, H, Dh)
    vc = v.reshape(B, N, CHUNK, H, Dh)
    scores = jnp.einsum('bnchd,bnshd->bnhcs', qc, kc) * intra_decay
    intra = jnp.einsum('bnhcs,bnshd->bnchd', scores, vc)

    def step(R, inp):
        qi, ki, vi = inp
        cross = jnp.einsum('bchd,bhde->bche', qi, R) * q_decay[None, :, :, None]
        R = R * chunk_decay[None, :, None, None] + jnp.einsum(
            'bchd,bche->bhde', ki * k_decay[None, :, :, None], vi)
        return R, cross

    R0 = jnp.zeros((B, H, Dh, Dh), jnp.float32)
    xs = (jnp.moveaxis(qc, 1, 0), jnp.moveaxis(kc, 1, 0), jnp.moveaxis(vc, 1, 0))
    _, cross = lax.scan(step, R0, xs)
    cross = jnp.moveaxis(cross, 0, 1)
    return (intra + cross).reshape(B, S, H, Dh)


def _retention_branch(q, k, v, g, pos, w_o):
    B, S, _ = q.shape
    shp = (B, S, RET_HEADS, RET_HEAD_DIM)
    qh = _rotary(q.astype(jnp.float32).reshape(shp), pos)
    kh = _rotary(k.astype(jnp.float32).reshape(shp), pos) * RET_HEAD_DIM ** -0.5
    vh = v.astype(jnp.float32).reshape(shp)
    o = _retention_core(qh, kh, vh)
    o = o * lax.rsqrt(jnp.mean(o * o, -1, keepdims=True) + RET_NORM_EPS)
    o = o.reshape(B, S, RET_WIDTH) * jax.nn.silu(g.astype(jnp.float32))
    return o.astype(q.dtype) @ w_o


def _rwkv7_recurrence(r, w, k, v, a, b):
    B, S, H, N = r.shape

    def step(state, inp):
        r_t, w_t, k_t, v_t, a_t, b_t = inp
        sa = jnp.einsum('bhij,bhj->bhi', state, a_t)
        state = (state * w_t[:, :, None, :] + sa[..., None] * b_t[:, :, None, :]
                 + v_t[..., None] * k_t[:, :, None, :])
        y = jnp.einsum('bhij,bhj->bhi', state, r_t)
        return state, y

    xs = tuple(jnp.moveaxis(t, 1, 0) for t in (r, w, k, v, a, b))
    _, y = lax.scan(step, jnp.zeros((B, H, N, N), jnp.float32), xs)
    return jnp.moveaxis(y, 0, 1)


def _rwkv7_branch(z, v_first, vres, w0, w2, a0, a2, g2, k_k, k_a, r_k, lnx_g, lnx_b, w_o):
    B, S, _ = z.shape
    f32 = jnp.float32
    r, k, v, wl, al, gl = _split(z, [RWKV_WIDTH] * 3 + [DECAY_LORA, AAA_LORA, GATE_LORA])
    w_log = -jax.nn.softplus(-(w0 + jnp.tanh(wl) @ w2)) - 0.5
    decay = jnp.exp(-jnp.exp(w_log.astype(f32)))
    a = jax.nn.sigmoid(a0 + al @ a2)
    if vres is None:
        v_first = v
    else:
        vl, v0, v2 = vres
        v = v + (v_first - v) * jax.nn.sigmoid(v0 + vl @ v2)
    g = jax.nn.sigmoid(gl) @ g2

    def heads(t):
        return t.astype(f32).reshape(B, S, RWKV_HEADS, RWKV_HEAD_DIM)

    kk = heads(k * k_k)
    kk = kk / jnp.maximum(jnp.sqrt(jnp.sum(kk * kk, -1, keepdims=True)), 1e-12)
    k = k * (1.0 + (a - 1.0) * k_a)
    rh, kh, vh, ah = heads(r), heads(k), heads(v), heads(a)
    y = _rwkv7_recurrence(rh, heads(decay), kh, vh, -kk, kk * ah)
    yc = y - jnp.mean(y, -1, keepdims=True)
    yn = yc * lax.rsqrt(jnp.mean(yc * yc, -1, keepdims=True) + LNX_EPS)
    yn = yn.reshape(B, S, RWKV_WIDTH) * lnx_g + lnx_b
    bonus = jnp.sum(rh * kh * r_k, -1, keepdims=True) * vh
    y = yn + bonus.reshape(B, S, RWKV_WIDTH)
    return (y * g).astype(z.dtype) @ w_o, v_first


def _causal_dwconv(z, w, b):
    S = z.shape[1]
    zp = jnp.pad(z, ((0, 0), (CONV_WIDTH - 1, 0), (0, 0)))
    out = zp[:, 0:S] * w[0]
    for j in range(1, CONV_WIDTH):
        out = out + zp[:, j:j + S] * w[j]
    return out + b


def setup_inputs(seed: int = 0) -> dict:
    key = jax.random.key(seed)
    ks = iter(jax.random.split(key, 40))
    f32 = jnp.float32
    L, D = DEPTH, D_MODEL
    beta = DEEPNORM_BETA

    def nrm(shape, scale):
        return jax.random.normal(next(ks), shape, f32) * scale

    x = nrm((BATCH, SEQ, D), 1.0)
    col_scale = np.ones((IN_WIDTH,), np.float32)
    col_scale[2 * RET_WIDTH:3 * RET_WIDTH] = beta
    rv = 4 * RET_WIDTH + 2 * RWKV_WIDTH
    col_scale[rv:rv + RWKV_WIDTH] = beta
    w_in = nrm((L, D, IN_WIDTH), D ** -0.5) * jnp.asarray(col_scale)
    mu_shift = jax.random.uniform(next(ks), (L, RWKV_SHIFT_WIDTH), f32)
    w_vres_in = nrm((L - 1, D, MV_LORA), D ** -0.5)
    mu_vres = jax.random.uniform(next(ks), (L - 1, MV_LORA), f32)
    v0 = 1.0 + nrm((L - 1, RWKV_WIDTH), 0.1)
    v2 = nrm((L - 1, MV_LORA, RWKV_WIDTH), MV_LORA ** -0.5)
    w0 = jax.random.uniform(next(ks), (L, RWKV_WIDTH), f32, -3.0, 0.0)
    w2 = nrm((L, DECAY_LORA, RWKV_WIDTH), 0.5 * DECAY_LORA ** -0.5)
    a0 = nrm((L, RWKV_WIDTH), 0.1)
    a2 = nrm((L, AAA_LORA, RWKV_WIDTH), AAA_LORA ** -0.5)
    g2 = nrm((L, GATE_LORA, RWKV_WIDTH), GATE_LORA ** -0.5)
    k_k = 0.85 + nrm((L, RWKV_WIDTH), 0.05)
    k_a = 1.0 + nrm((L, RWKV_WIDTH), 0.05)
    r_k = nrm((L, RWKV_HEADS, RWKV_HEAD_DIM), 0.1)
    lnx_g = 1.0 + nrm((L, RWKV_WIDTH), 0.05)
    lnx_b = nrm((L, RWKV_WIDTH), 0.02)
    w_ret_o = nrm((L, RET_WIDTH, D), RET_WIDTH ** -0.5 * beta)
    w_rwkv_o = nrm((L, RWKV_WIDTH, D), RWKV_WIDTH ** -0.5 * beta)
    w_out = nrm((L, D, D), D ** -0.5 * beta)
    ln1_g = 1.0 + nrm((L, D), 0.05)
    ln1_b = nrm((L, D), 0.02)
    w_up = nrm((L, D, 2 * D_FF), D ** -0.5)
    conv_w = nrm((L, CONV_WIDTH, D_FF), CONV_WIDTH ** -0.5)
    conv_b = nrm((L, D_FF), 0.02)
    w_down = nrm((L, D_FF, D), D_FF ** -0.5 * beta)
    ln2_g = 1.0 + nrm((L, D), 0.05)
    ln2_b = nrm((L, D), 0.02)
    return {'x': x, 'w_in': w_in, 'mu_shift': mu_shift, 'w_vres_in': w_vres_in,
            'mu_vres': mu_vres, 'v0': v0, 'v2': v2, 'w0': w0, 'w2': w2, 'a0': a0,
            'a2': a2, 'g2': g2, 'k_k': k_k, 'k_a': k_a, 'r_k': r_k, 'lnx_g': lnx_g,
            'lnx_b': lnx_b, 'w_ret_o': w_ret_o, 'w_rwkv_o': w_rwkv_o, 'w_out': w_out,
            'ln1_g': ln1_g, 'ln1_b': ln1_b, 'w_up': w_up, 'conv_w': conv_w,
            'conv_b': conv_b, 'w_down': w_down, 'ln2_g': ln2_g, 'ln2_b': ln2_b}


def reference(x, w_in, mu_shift, w_vres_in, mu_vres, v0, v2, w0, w2, a0, a2, g2, k_k, k_a,
              r_k, lnx_g, lnx_b, w_ret_o, w_rwkv_o, w_out, ln1_g, ln1_b, w_up, conv_w,
              conv_b, w_down, ln2_g, ln2_b):
    dtype = x.dtype
    S = x.shape[1]
    pos = jnp.arange(S, dtype=jnp.float32)
    v_first = None
    for l in range(DEPTH):
        if l == 0:
            h = x @ w_in[0]
            vres_in = None
        else:
            h = x @ jnp.concatenate([w_in[l], w_vres_in[l - 1]], axis=1)
        q, k, v, g_ret, rw, gate_a, gate_b = _split(
            h, [RET_WIDTH] * 4 + [RWKV_SHIFT_WIDTH, D_MODEL, D_MODEL])
        if l > 0:
            vl = _token_shift(h[..., IN_WIDTH:], mu_vres[l - 1])
            vres_in = (vl, v0[l - 1], v2[l - 1])
        ret_out = _retention_branch(q, k, v, g_ret, pos, w_ret_o[l])
        rwkv_out, v_first = _rwkv7_branch(
            _token_shift(rw, mu_shift[l]), v_first, vres_in, w0[l], w2[l], a0[l], a2[l],
            g2[l], k_k[l], k_a[l], r_k[l], lnx_g[l], lnx_b[l], w_rwkv_o[l])
        mixed = jax.nn.sigmoid(gate_a) * ret_out + jax.nn.sigmoid(gate_b) * rwkv_out
        x = _layer_norm(DEEPNORM_ALPHA * x + mixed @ w_out[l], ln1_g[l], ln1_b[l]).astype(dtype)
        up = x @ w_up[l]
        gate = _causal_dwconv(up[..., :D_FF], conv_w[l], conv_b[l])
        ffn = (jax.nn.silu(gate) * up[..., D_FF:]) @ w_down[l]
        x = _layer_norm(DEEPNORM_ALPHA * x + ffn, ln2_g[l], ln2_b[l]).astype(dtype)
    return x
```

```cpp
#include <hip/hip_runtime.h>
#include <hip/hip_cooperative_groups.h>
#include <cstdio>
#include <cstdint>
namespace cg = cooperative_groups;
namespace pg8 {
#define PG8_LAS __attribute__((address_space(3)))
typedef unsigned short bf16_t;
typedef short bf16x8 __attribute__((ext_vector_type(8)));
typedef float f32x4 __attribute__((ext_vector_type(4)));
typedef unsigned u32x4 __attribute__((ext_vector_type(4)));
constexpr int BM = 256, BK = 64, HALF = 128, HTB = HALF * BK * 2  , STAGE_BYTES = 8 * HTB, NXCD = 8, WGM = 8;

__host__ __device__ __forceinline__ int lds_byte(int r, int c) { const int st = (r >> 4) * 2 + (c >> 5), rr = r & 15, cc = c & 31, ob = rr * 64 + cc * 2; return st * 1024 + (ob ^ (((ob >> 9) & 1) << 5)); }
__host__ __device__ __forceinline__ void stage_rc(int b, int& R, int& C) { const int st = b / 1024, sb = b % 1024, swz = sb ^ (((sb >> 9) & 1) << 5); R = (st >> 1) * 16 + swz / 64; C = (st & 1) * 32 + (swz % 64) / 2; }
__host__ __device__ __forceinline__ int perm32(int rho) { const int n = rho >> 4, i = rho & 15; return 8 * (i >> 2) + 4 * n + (i & 3); }

struct Unit { int pm, pn; };
struct Gemm { const bf16_t* A; const bf16_t* Bt; int M, N, K, lda; };

struct StaticOrder {
    int nM, nN, nwg, G, c;
    __host__ __device__ void init(int M, int N, int G_, int c_) { nM = M / BM; nN = N / BM; nwg = nM * nN; G = G_; c = c_; }
    __host__ __device__ bool next(int i, Unit& u) const {
        const long L = (long)i * G + c; if (L >= nwg) return false;
        int wgid = (int)L; { const int q = nwg / NXCD, r = nwg % NXCD, xcd = wgid % NXCD, off = wgid / NXCD; wgid = (xcd < r ? xcd * (q + 1) : r * (q + 1) + (xcd - r) * q) + off; }
        const int nig = WGM * nN, gid = wgid / nig, fm = gid * WGM, gsz = (nM - fm) < WGM ? (nM - fm) : WGM;
        u.pm = fm + ((wgid % nig) % gsz); u.pn = (wgid % nig) / gsz; return true;
    }
    __device__ __forceinline__ void a_ready(const Unit&) const {}
    __device__ __forceinline__ void done(const Unit&) const {}
};

__device__ __forceinline__ unsigned cvt_pk_bf16(float lo, float hi) { unsigned r; asm volatile("v_cvt_pk_bf16_f32 %0, %1, %2" : "=v"(r) : "v"(lo), "v"(hi)); return r; }
typedef float f32x2 __attribute__((ext_vector_type(2)));

template <class Epi, class Sched, bool ALIGN_EPI = false, bool SP2 = false>
__device__ __forceinline__ void gemm_phase(PG8_LAS unsigned char* lds, const Gemm g, const Sched& S, const Epi& E) {
    int tid = threadIdx.x; asm volatile("" : "+v"(tid)); const int wid = __builtin_amdgcn_readfirstlane(tid >> 6), lane = tid & 63, wr = wid >> 2, wc = wid & 3, fr = lane & 15, fq = lane >> 4;
    const int K = g.K, nt = K / BK;
    unsigned voffA[2], voffB[2];
#pragma unroll
    for (int i = 0; i < 2; ++i) { int R, C; stage_rc(tid * 16 + i * 8192, R, C); const int Rb = Epi::PERM ? ((R & ~31) + perm32(R & 31)) : R;
        voffA[i] = (unsigned)(R * g.lda + C) * 2u; voffB[i] = (unsigned)(Rb * K + C) * 2u; }
    const size_t kstep = (size_t)(BK * 2);
    const size_t hstepA = (size_t)HALF * g.lda * 2, hstepB = (size_t)HALF * K * 2;
    const size_t tstepA = 2 * hstepA, tstepB = 2 * hstepB;
    const unsigned ldsw = (unsigned)wid * 1024u;
    const int aoff = lds_byte(wr * 64 + fr, fq * 8), boff = lds_byte(wc * 32 + fr, fq * 8);
#define PG8_SA(b, h) (((b) * 2 + (h)) * HTB)
#define PG8_SB(b, h) ((4 + (b) * 2 + (h)) * HTB)
#define PG8_STAGE(bufoff, gbase, voff) do { _Pragma("unroll") for (int _i = 0; _i < 2; ++_i) \
        __builtin_amdgcn_global_load_lds((const unsigned*)((const char*)(gbase) + (voff)[_i]), (PG8_LAS unsigned*)(lds + (bufoff) + ldsw + _i * 8192), 16, 0, 0); } while (0)
#define PG8_LDA(dst, b, h) do { _Pragma("unroll") for (int m = 0; m < 4; ++m) _Pragma("unroll") for (int k = 0; k < 2; ++k) dst[m][k] = *(const PG8_LAS bf16x8*)(lds + PG8_SA(b, h) + aoff + m * 2048 + k * 1024); } while (0)
#define PG8_LDB(dst, b, h) do { _Pragma("unroll") for (int n = 0; n < 2; ++n) _Pragma("unroll") for (int k = 0; k < 2; ++k) dst[n][k] = *(const PG8_LAS bf16x8*)(lds + PG8_SB(b, h) + boff + n * 2048 + k * 1024); } while (0)
#define PG8_MMA(ai, bj, At, Bt) do { __builtin_amdgcn_s_setprio(1); _Pragma("unroll") for (int m = 0; m < 4; ++m) _Pragma("unroll") for (int n = 0; n < 2; ++n) _Pragma("unroll") for (int k = 0; k < 2; ++k) \
        acc[ai][bj][m][n] = __builtin_amdgcn_mfma_f32_16x16x32_bf16(Bt[n][k], At[m][k], acc[ai][bj][m][n], 0, 0, 0); __builtin_amdgcn_s_setprio(0); } while (0)
#define PG8_WAIT_V(n) asm volatile("s_waitcnt vmcnt(" #n ")" ::: "memory")
#define PG8_WAIT_L(n) asm volatile("s_waitcnt lgkmcnt(" #n ")" ::: "memory")
#define PG8_BAR __builtin_amdgcn_s_barrier()
#define PG8_SCHED __builtin_amdgcn_sched_barrier(0)
    Unit cur, nxt; int ui = 0;
    if (!S.next(0, cur)) return;
    f32x4 acc[2][2][4][2];
#pragma unroll
    for (int a = 0; a < 2; ++a)
#pragma unroll
        for (int b = 0; b < 2; ++b)
#pragma unroll
            for (int m = 0; m < 4; ++m)
#pragma unroll
                for (int n = 0; n < 2; ++n) acc[a][b][m][n] = (f32x4){0.f, 0.f, 0.f, 0.f};
    bf16x8 At[4][2], B0[2][2], B1[2][2];
    const char* cA = (const char*)g.A + (size_t)cur.pm * tstepA; const char* cB = (const char*)g.Bt + (size_t)cur.pn * tstepB;
    S.a_ready(cur);
    if constexpr (SP2) {
        PG8_STAGE(PG8_SB(0, 0), cB, voffB); PG8_STAGE(PG8_SB(0, 1), cB + hstepB, voffB); PG8_STAGE(PG8_SA(0, 0), cA, voffA); PG8_STAGE(PG8_SA(0, 1), cA + hstepA, voffA);
        if (wr == 1) PG8_BAR;
        PG8_WAIT_V(2); PG8_BAR;
        PG8_STAGE(PG8_SB(1, 0), cB + kstep, voffB); PG8_STAGE(PG8_SA(1, 0), cA + kstep, voffA); PG8_STAGE(PG8_SB(1, 1), cB + hstepB + kstep, voffB);
        PG8_WAIT_V(6); PG8_BAR;
    } else {
        PG8_STAGE(PG8_SB(0, 0), cB, voffB); PG8_STAGE(PG8_SA(0, 0), cA, voffA); PG8_STAGE(PG8_SB(0, 1), cB + hstepB, voffB); PG8_STAGE(PG8_SA(0, 1), cA + hstepA, voffA);
        if (wr == 1) PG8_BAR;
        PG8_WAIT_V(4); PG8_BAR;
        PG8_STAGE(PG8_SB(1, 0), cB + kstep, voffB); PG8_STAGE(PG8_SA(1, 0), cA + kstep, voffA); PG8_STAGE(PG8_SB(1, 1), cB + hstepB + kstep, voffB);
        PG8_WAIT_V(6); PG8_BAR;
    }
    for (;;) {
        const bool has_next = S.next(ui + 1, nxt);
        const char* nA = has_next ? (const char*)g.A + (size_t)nxt.pm * tstepA : cA; const char* nB = has_next ? (const char*)g.Bt + (size_t)nxt.pn * tstepB : cB;
        for (int t = 0; t < nt; t += 2) {
            const bool last = (t == nt - 2);
            const char* a1 = cA + (size_t)(t + 1) * kstep;
            const char* a2 = last ? nA : cA + (size_t)(t + 2) * kstep; const char* b2 = last ? nB : cB + (size_t)(t + 2) * kstep;
            const char* a3 = a2 + kstep; const char* b3 = b2 + kstep;
            if (last && has_next) S.a_ready(nxt);
            if constexpr (SP2) {
            PG8_LDB(B0, 0, 0); PG8_LDB(B1, 0, 1); PG8_SCHED; PG8_LDA(At, 0, 0); PG8_STAGE(PG8_SA(1, 1), a1 + hstepA, voffA);
            PG8_WAIT_V(8); PG8_WAIT_L(0); PG8_BAR; PG8_MMA(0, 0, At, B0); PG8_MMA(0, 1, At, B1); PG8_BAR; PG8_SCHED;
            PG8_LDA(At, 0, 1); PG8_STAGE(PG8_SB(0, 0), b2, voffB); PG8_STAGE(PG8_SB(0, 1), b2 + hstepB, voffB); PG8_STAGE(PG8_SA(0, 0), a2, voffA);
            PG8_WAIT_V(8); PG8_WAIT_L(0); PG8_BAR; PG8_MMA(1, 0, At, B0); PG8_MMA(1, 1, At, B1); PG8_BAR; PG8_SCHED;
            PG8_LDB(B0, 1, 0); PG8_LDB(B1, 1, 1); PG8_SCHED; PG8_LDA(At, 1, 0); PG8_STAGE(PG8_SA(0, 1), a2 + hstepA, voffA);
            PG8_WAIT_V(8); PG8_WAIT_L(0); PG8_BAR; PG8_MMA(0, 0, At, B0); PG8_MMA(0, 1, At, B1); PG8_BAR; PG8_SCHED;
            PG8_LDA(At, 1, 1); PG8_STAGE(PG8_SB(1, 0), b3, voffB); PG8_STAGE(PG8_SB(1, 1), b3 + hstepB, voffB); PG8_STAGE(PG8_SA(1, 0), a3, voffA);
            PG8_WAIT_V(8); PG8_WAIT_L(0); PG8_BAR; PG8_MMA(1, 0, At, B0); PG8_MMA(1, 1, At, B1); PG8_BAR; PG8_SCHED;
            } else {
            PG8_LDB(B0, 0, 0); PG8_SCHED; PG8_LDA(At, 0, 0); PG8_STAGE(PG8_SA(1, 1), a1 + hstepA, voffA);
            PG8_WAIT_L(8); PG8_BAR; PG8_WAIT_L(0); PG8_MMA(0, 0, At, B0); PG8_BAR; PG8_SCHED;
            PG8_LDB(B1, 0, 1); PG8_STAGE(PG8_SB(0, 0), b2, voffB);
            PG8_BAR; PG8_WAIT_L(0); PG8_MMA(0, 1, At, B1); PG8_BAR;
            PG8_LDA(At, 0, 1); PG8_STAGE(PG8_SA(0, 0), a2, voffA);
            PG8_BAR; PG8_WAIT_L(0); PG8_MMA(1, 0, At, B0); PG8_BAR; PG8_SCHED;
            PG8_STAGE(PG8_SB(0, 1), b2 + hstepB, voffB);
            PG8_WAIT_V(6); PG8_BAR; PG8_MMA(1, 1, At, B1); PG8_BAR;
            PG8_LDB(B0, 1, 0); PG8_SCHED; PG8_LDA(At, 1, 0); PG8_STAGE(PG8_SA(0, 1), a2 + hstepA, voffA);
            PG8_WAIT_L(8); PG8_BAR; PG8_WAIT_L(0); PG8_MMA(0, 0, At, B0); PG8_BAR; PG8_SCHED;
            PG8_LDB(B1, 1, 1); PG8_STAGE(PG8_SB(1, 0), b3, voffB);
            PG8_BAR; PG8_WAIT_L(0); PG8_MMA(0, 1, At, B1); PG8_BAR;
            PG8_LDA(At, 1, 1); PG8_STAGE(PG8_SA(1, 0), a3, voffA);
            PG8_BAR; PG8_WAIT_L(0); PG8_MMA(1, 0, At, B0); PG8_BAR; PG8_SCHED;
            PG8_STAGE(PG8_SB(1, 1), b3 + hstepB, voffB);
            PG8_WAIT_V(6); PG8_BAR; PG8_MMA(1, 1, At, B1); PG8_BAR;
            }
        }
        if constexpr (ALIGN_EPI) { if (wr == 0) PG8_BAR; }
        if constexpr (!Epi::AFTER_DRAIN) { E(acc, cur, wr, wc, fr, fq); S.done(cur); }
        if (!has_next) break;
#pragma unroll
        for (int a = 0; a < 2; ++a)
#pragma unroll
            for (int b = 0; b < 2; ++b)
#pragma unroll
                for (int m = 0; m < 4; ++m)
#pragma unroll
                    for (int n = 0; n < 2; ++n) acc[a][b][m][n] = (f32x4){0.f, 0.f, 0.f, 0.f};
        cur = nxt; cA = nA; cB = nB; ++ui;
        if constexpr (ALIGN_EPI) { if (wr == 1) PG8_BAR; }
    }
    PG8_WAIT_V(0);
    if constexpr (!ALIGN_EPI) { if (wr == 0) PG8_BAR; }
    PG8_BAR;
    if constexpr (Epi::AFTER_DRAIN) { E.fused(acc, cur, wr, wc, fr, fq, lds, wid, lane); S.done(cur); }
#undef PG8_SA
#undef PG8_SB
#undef PG8_STAGE
#undef PG8_LDA
#undef PG8_LDB
#undef PG8_MMA
#undef PG8_WAIT_V
#undef PG8_WAIT_L
#undef PG8_BAR
#undef PG8_SCHED
}
}

using pg8::bf16_t; using pg8::f32x4; using pg8::bf16x8; using pg8::u32x4; using pg8::cvt_pk_bf16;
#define LAS __attribute__((address_space(3)))
constexpr int NTHR = 512;
constexpr int TT = 32768, SEQ = 4096, DM = 1024, HP = 5952, UPP = 5632, DFF = 2816;
constexpr int HQ = 0, HK = 512, HV = 1024, HG = 1536, HRW = 2048, HGA = 3872, HGB = 4896, HVL = 5920;
constexpr int C_RETIN = HQ, C_RS = HK, C_LD = HV, C_AA = HG, C_Y = HRW, C_G = HRW + 512;
constexpr float ALPHA = 1.4142135623730951f;
constexpr size_t OFF_TAB = 65536, OFF_BONUS = OFF_TAB + 1048576, OFF_STATS = OFF_BONUS + 1048576, OFF_W = OFF_STATS + 8388608;
constexpr size_t W_WIN = 0, W_LORA = 6291456, W_G2T = 6684672, W_RETO = 6815744, W_RWKVO = 7340032, W_WOUT = 7864320, W_WUP = 8912896, W_WDOWN = 14680064, W_END = 17563648;
constexpr size_t OFF_VF = OFF_W + W_END * 2, OFF_XB = OFF_VF + (size_t)TT * 512 * 2, OFF_H = OFF_XB + (size_t)TT * 1024 * 2, WS_END = OFF_H + (size_t)TT * HP * 2;
static_assert(WS_END <= 536870912ull, "workspace map");
constexpr int LDS_BYTES = 147456;

struct Params { const float* in[28]; float* out; unsigned char* ws; };
__device__ __forceinline__ int obid() { int t = blockIdx.x; asm volatile("" : "+s"(t)); return t; }
__device__ __forceinline__ int otid() { int t = threadIdx.x; asm volatile("" : "+v"(t)); return t; }

__device__ __forceinline__ float bflo(unsigned u) { return __uint_as_float(u << 16); }
__device__ __forceinline__ float bfhi(unsigned u) { return __uint_as_float(u & 0xffff0000u); }
__device__ __forceinline__ void unpack8(const u32x4 v, float (&f)[8]) { f[0] = bflo(v.x); f[1] = bfhi(v.x); f[2] = bflo(v.y); f[3] = bfhi(v.y); f[4] = bflo(v.z); f[5] = bfhi(v.z); f[6] = bflo(v.w); f[7] = bfhi(v.w); }
__device__ __forceinline__ u32x4 pack8(const float (&f)[8]) { u32x4 w; w.x = cvt_pk_bf16(f[0], f[1]); w.y = cvt_pk_bf16(f[2], f[3]); w.z = cvt_pk_bf16(f[4], f[5]); w.w = cvt_pk_bf16(f[6], f[7]); return w; }
__device__ __forceinline__ u32x4 ldg16(const void* p) { return *(const u32x4*)p; }
__device__ __forceinline__ void ld8f(const float* p, float (&f)[8]) { const f32x4 a = *(const f32x4*)p, b = *(const f32x4*)(p + 4); f[0] = a.x; f[1] = a.y; f[2] = a.z; f[3] = a.w; f[4] = b.x; f[5] = b.y; f[6] = b.z; f[7] = b.w; }
__device__ __forceinline__ unsigned short f2bf1(float f) { return (unsigned short)(cvt_pk_bf16(f, 0.f) & 0xffffu); }
__device__ __forceinline__ float sigmoidf_(float x) { return 1.0f / (1.0f + __expf(-x)); }
__device__ __forceinline__ float siluf_(float x) { return x / (1.0f + __expf(-x)); }
template <int N> __device__ __forceinline__ float dpp_ror(float v) { return __builtin_bit_cast(float, __builtin_amdgcn_update_dpp(0, __builtin_bit_cast(int, v), 0x120 + N, 0xf, 0xf, false)); }
__device__ __forceinline__ float row16_sum(float v) { v += dpp_ror<8>(v); v += dpp_ror<4>(v); v += dpp_ror<2>(v); v += dpp_ror<1>(v); return v; }
__device__ __forceinline__ float wave_sum(float v) {
#pragma unroll
    for (int o = 1; o < 64; o <<= 1) v += __shfl_xor(v, o);
    return v;
}

__device__ __forceinline__ const float* gin(LAS unsigned char* lds, int i);
struct EpiStore {
    static constexpr bool PERM = true, AFTER_DRAIN = false;
    LAS unsigned char* lds; int ldc; int nvalid; int coff;
    __device__ __forceinline__ void operator()(const f32x4 (&acc)[2][2][4][2], const pg8::Unit& u, int wr, int wc, int fr, int fq) const {
        asm volatile("" : "+v"(fr), "+v"(fq), "+s"(wr), "+s"(wc));
        const int row0 = u.pm * 256 + wr * 64 + fr, col0 = u.pn * 256 + wc * 32 + 8 * fq;
        bf16_t* O = (bf16_t*)((unsigned char*)gin(lds, 29) + OFF_H) + coff;
#pragma unroll
        for (int ai = 0; ai < 2; ++ai)
#pragma unroll
            for (int m = 0; m < 4; ++m) { bf16_t* rowp = O + (size_t)(row0 + ai * 128 + m * 16) * ldc + col0;
#pragma unroll
                for (int bj = 0; bj < 2; ++bj) { const f32x4 v0 = acc[ai][bj][m][0], v1 = acc[ai][bj][m][1];
                    u32x4 w; w.x = cvt_pk_bf16(v0[0], v0[1]); w.y = cvt_pk_bf16(v0[2], v0[3]); w.z = cvt_pk_bf16(v1[0], v1[1]); w.w = cvt_pk_bf16(v1[2], v1[3]);
                    if (col0 + bj * 128 < nvalid) *(u32x4*)(rowp + bj * 128) = w; } }
    }
};
struct EpiLora {
    static constexpr bool PERM = true, AFTER_DRAIN = false;
    LAS unsigned char* lds; int layer;
    __device__ __forceinline__ void operator()(const f32x4 (&acc)[2][2][4][2], const pg8::Unit& u, int wr, int wc, int fr, int fq) const {
        asm volatile("" : "+v"(fr), "+v"(fq), "+s"(wr), "+s"(wc));
        const int kind = u.pn >> 1; const int row0 = u.pm * 256 + wr * 64 + fr, cb = (u.pn & 1) * 256 + wc * 32 + 8 * fq;
        if (kind == 2 && layer == 0) return;
        bf16_t* H = (bf16_t*)((unsigned char*)gin(lds, 29) + OFF_H) + (kind == 0 ? C_LD : (kind == 1 ? C_AA : C_Y));
        const float* bias = kind == 0 ? gin(lds, 7) + layer * 512 : (kind == 1 ? gin(lds, 9) + layer * 512 : gin(lds, 5));
#pragma unroll
        for (int bj = 0; bj < 2; ++bj) { const int c = cb + bj * 128;
            float bias8[8]; ld8f(bias + c, bias8);
#pragma unroll
            for (int ai = 0; ai < 2; ++ai)
#pragma unroll
                for (int m = 0; m < 4; ++m) { const int row = row0 + ai * 128 + m * 16;
                    const f32x4 v0_ = acc[ai][bj][m][0], v1_ = acc[ai][bj][m][1];
                    const float a8[8] = {v0_[0], v0_[1], v0_[2], v0_[3], v1_[0], v1_[1], v1_[2], v1_[3]};
                    float o[8];
                    if (kind == 0) {
#pragma unroll
                        for (int e = 0; e < 8; ++e) { const float uu = bias8[e] + a8[e]; const float wl = -__logf(1.0f + __expf(-uu)) - 0.5f; o[e] = -__expf(wl); }
                    } else {
#pragma unroll
                        for (int e = 0; e < 8; ++e) o[e] = sigmoidf_(bias8[e] + a8[e]);
                    }
                    *(u32x4*)(H + (size_t)row * HP + c) = pack8(o); } }
    }
};
struct EpiMerge {
    static constexpr bool PERM = true, AFTER_DRAIN = false;
    LAS unsigned char* lds; int gcol; int accum;
    __device__ __forceinline__ void operator()(const f32x4 (&acc)[2][2][4][2], const pg8::Unit& u, int wr, int wc, int fr, int fq) const {
        asm volatile("" : "+v"(fr), "+v"(fq), "+s"(wr), "+s"(wc));
        const int row0 = u.pm * 256 + wr * 64 + fr, cb = u.pn * 256 + wc * 32 + 8 * fq;
        unsigned char* wsb = (unsigned char*)gin(lds, 29); const bf16_t* H = (const bf16_t*)(wsb + OFF_H); bf16_t* MIX = (bf16_t*)(wsb + OFF_XB);
#pragma unroll
        for (int ai = 0; ai < 2; ++ai)
#pragma unroll
            for (int m = 0; m < 4; ++m) { const int row = row0 + ai * 128 + m * 16;
#pragma unroll
                for (int bj = 0; bj < 2; ++bj) { const int c = cb + bj * 128;
                    float gt[8], o[8]; unpack8(ldg16(H + (size_t)row * HP + gcol + c), gt);
                    const f32x4 v0_ = acc[ai][bj][m][0], v1_ = acc[ai][bj][m][1];
                    const float a8[8] = {v0_[0], v0_[1], v0_[2], v0_[3], v1_[0], v1_[1], v1_[2], v1_[3]};
#pragma unroll
                    for (int e = 0; e < 8; ++e) o[e] = sigmoidf_(gt[e]) * a8[e];
                    bf16_t* mp = MIX + (size_t)row * 1024 + c;
                    if (accum) { float pv[8]; unpack8(ldg16(mp), pv);
#pragma unroll
                        for (int e = 0; e < 8; ++e) o[e] += pv[e]; }
                    *(u32x4*)mp = pack8(o); } }
    }
};
struct EpiResid {
    static constexpr bool PERM = false, AFTER_DRAIN = false;
    LAS unsigned char* lds; int xin;
    __device__ __forceinline__ void operator()(const f32x4 (&acc)[2][2][4][2], const pg8::Unit& u, int wr, int wc, int fr, int fq) const {
        asm volatile("" : "+v"(fr), "+v"(fq), "+s"(wr), "+s"(wc));
        const int row0 = u.pm * 256 + wr * 64 + fr, col0 = u.pn * 256 + wc * 32 + 4 * fq;
        float* out = (float*)gin(lds, 28); const float* xres = xin ? gin(lds, 0) : (const float*)out;
#pragma unroll
        for (int ai = 0; ai < 2; ++ai)
#pragma unroll
            for (int m = 0; m < 4; ++m) { const size_t off = (size_t)(row0 + ai * 128 + m * 16) * DM + col0;
#pragma unroll
                for (int bj = 0; bj < 2; ++bj)
#pragma unroll
                    for (int n = 0; n < 2; ++n) { const f32x4 x = *(const f32x4*)(xres + off + bj * 128 + n * 16); *(f32x4*)(out + off + bj * 128 + n * 16) = x * ALPHA + acc[ai][bj][m][n]; } }
    }
};

template <class Epi> __device__ __forceinline__ void run_gemm(LAS unsigned char* lds, const bf16_t* A, int lda, const bf16_t* Bt, int N, int K, const Epi& E) {
    asm volatile("" : "+s"(K), "+s"(N), "+s"(lda));
    pg8::Gemm g{A, Bt, TT, N, K, lda}; pg8::StaticOrder S; S.init(TT, N, (int)gridDim.x, obid());
    pg8::gemm_phase<Epi, pg8::StaticOrder, true, true>(lds, g, S, E);
}

__device__ __forceinline__ void tr_block(const float* W, int N, int k0, int n0, bf16_t* WT, int ldk, int drow0, LAS float* scr, int lane) {
#pragma unroll 8
    for (int i = 0; i < 32; ++i) { const int kk = 2 * i + (lane >> 5); scr[kk * 33 + (lane & 31)] = W[(size_t)(k0 + kk) * N + n0 + (lane & 31)]; }
    asm volatile("s_waitcnt lgkmcnt(0)" ::: "memory");
    const int c = lane & 7;
#pragma unroll
    for (int j = 0; j < 4; ++j) { const int n = (lane >> 3) + 8 * j; const LAS float* s = scr + (8 * c) * 33 + n;
        u32x4 o; o.x = cvt_pk_bf16(s[0 * 33], s[1 * 33]); o.y = cvt_pk_bf16(s[2 * 33], s[3 * 33]); o.z = cvt_pk_bf16(s[4 * 33], s[5 * 33]); o.w = cvt_pk_bf16(s[6 * 33], s[7 * 33]);
        *(u32x4*)(WT + (size_t)(drow0 + n) * ldk + k0 + 8 * c) = o; }
    asm volatile("s_waitcnt lgkmcnt(0)" ::: "memory");
}
__device__ __forceinline__ bool tr_seg(int& it, const float* W, int K, int N, bf16_t* WT, int drow_base, LAS float* scr, int lane) {
    const int nblk = N / 32, items = (K / 64) * nblk;
    if (it < items) { const int kb = it / nblk, nb = it % nblk; tr_block(W, N, kb * 64, nb * 32, WT, K, drow_base + nb * 32, scr, lane); return true; }
    it -= items; return false;
}
__device__ __forceinline__ const float* gin(LAS unsigned char* lds, int i);
__device__ __forceinline__ void weights_phase(LAS unsigned char* lds, int l) {
    unsigned char* wsb = (unsigned char*)gin(lds, 29);
    const int tid = otid(), lane = tid & 63, wave = tid >> 6;
    LAS float* scr = (LAS float*)(lds + wave * 8704);
    bf16_t* WB = (bf16_t*)(wsb + OFF_W);
    const int gw = obid() * 8 + wave, NGW = gridDim.x * 8;
    constexpr int NITEMS = 2960 + 16 + 256 + 256 + 512 + 2816 + 1408;
    for (int it0 = gw; it0 < NITEMS; it0 += NGW) { int it = it0;
        if (tr_seg(it, gin(lds, 1) + (size_t)l * 1024 * 5920, 1024, 5920, WB + W_WIN, 0, scr, lane)) continue;
        if (it < 16) { if (l == 1) tr_block(gin(lds, 3), 32, it * 64, 0, WB + W_WIN, 1024, 5920, scr, lane); continue; } it -= 16;
        if (tr_seg(it, gin(lds, 17) + (size_t)l * 512 * 1024, 512, 1024, WB + W_RETO, 0, scr, lane)) continue;
        if (tr_seg(it, gin(lds, 18) + (size_t)l * 512 * 1024, 512, 1024, WB + W_RWKVO, 0, scr, lane)) continue;
        if (tr_seg(it, gin(lds, 19) + (size_t)l * 1024 * 1024, 1024, 1024, WB + W_WOUT, 0, scr, lane)) continue;
        if (tr_seg(it, gin(lds, 22) + (size_t)l * 1024 * 5632, 1024, 5632, WB + W_WUP, 0, scr, lane)) continue;
        tr_seg(it, gin(lds, 25) + (size_t)l * 2816 * 1024, 2816, 1024, WB + W_WDOWN, 0, scr, lane);
    }
    const int gt = obid() * NTHR + tid, NGT = gridDim.x * NTHR;
    const int nv = 5920 + 32 * l;
    for (int i = gt; i < (6144 - nv) * 1024 / 8; i += NGT) *(u32x4*)(WB + W_WIN + (size_t)nv * 1024 + (size_t)i * 8) = (u32x4){0u, 0u, 0u, 0u};
    const float* w2 = gin(lds, 8) + (size_t)l * 64 * 512; const float* a2 = gin(lds, 10) + (size_t)l * 64 * 512; const float* v2 = gin(lds, 6); const float* g2 = gin(lds, 11) + (size_t)l * 160 * 512;
    for (int i = gt; i < 1536 * 256; i += NGT) { const int n = i >> 8, k = i & 255, kind = n >> 9, c = n & 511; float v = 0.f;
        if (kind == 0) { if (k < 64) v = w2[k * 512 + c]; }
        else if (kind == 1) { if (k >= 64 && k < 128) v = a2[(k - 64) * 512 + c]; }
        else { if (l == 1 && k >= 128 && k < 160) v = v2[(k - 128) * 512 + c]; }
        WB[W_LORA + i] = f2bf1(v); }
    for (int i = gt; i < 512 * 256; i += NGT) { const int n = i >> 8, k = i & 255; WB[W_G2T + i] = f2bf1(k < 160 ? g2[k * 512 + n] : 0.f); }
}
__device__ __forceinline__ void x_phase(const float* x, unsigned char* wsb) {
    const int gt = obid() * NTHR + otid(), NGT = gridDim.x * NTHR;
    bf16_t* XB = (bf16_t*)(wsb + OFF_XB);
    for (int i = gt; i < TT * DM / 8; i += NGT) { float f[8]; ld8f(x + (size_t)i * 8, f); *(u32x4*)(XB + (size_t)i * 8) = pack8(f); }
    unsigned* TAB = (unsigned*)(wsb + OFF_TAB);
    for (int i = gt; i < SEQ * 64; i += NGT) { const int pos = i >> 6, f = i & 63;
        const float inv = powf(10000.0f, -(float)f / 64.0f); const float ang = (float)pos * inv;
        const float c = cosf(ang), s = sinf(ang);
        const unsigned lo = __builtin_bit_cast(unsigned short, (_Float16)c), hi = __builtin_bit_cast(unsigned short, (_Float16)s);
        TAB[i] = lo | (hi << 16); }
}

__device__ __forceinline__ void ln_phase(float* X, const float* g, const float* b, bf16_t* XB) {
    const int tid_ = otid(); const int lane = tid_ & 63, wave = tid_ >> 6;
    const int gw = obid() * 8 + wave, NGW = gridDim.x * 8;
    f32x4 gv[4], bv[4];
#pragma unroll
    for (int j = 0; j < 4; ++j) { gv[j] = *(const f32x4*)(g + 4 * lane + 256 * j); bv[j] = *(const f32x4*)(b + 4 * lane + 256 * j); }
    for (int m = gw; m < TT; m += NGW) {
        f32x4* xr = (f32x4*)(X + (size_t)m * DM) + lane;
        f32x4 v[4]; float s = 0.f;
#pragma unroll
        for (int j = 0; j < 4; ++j) { v[j] = xr[64 * j]; s += (v[j].x + v[j].y) + (v[j].z + v[j].w); }
        const float mean = wave_sum(s) * (1.f / DM); float s2 = 0.f;
#pragma unroll
        for (int j = 0; j < 4; ++j) { v[j] = v[j] - mean; s2 += (v[j].x * v[j].x + v[j].y * v[j].y) + (v[j].z * v[j].z + v[j].w * v[j].w); }
        const float rstd = rsqrtf(wave_sum(s2) * (1.f / DM) + 1e-5f);
#pragma unroll
        for (int j = 0; j < 4; ++j) { const f32x4 o = v[j] * rstd * gv[j] + bv[j]; xr[64 * j] = o;
            if (XB) { unsigned lo = cvt_pk_bf16(o.x, o.y), hi = cvt_pk_bf16(o.z, o.w); *(unsigned long long*)(XB + (size_t)m * DM + 4 * lane + 256 * j) = (unsigned long long)lo | ((unsigned long long)hi << 32); } }
    }
}

__device__ __forceinline__ void act_phase(bf16_t* UP, const float* cw, const float* cb) {
    const int gt = obid() * NTHR + otid(), NGT = gridDim.x * NTHR;
    for (int i = gt; i < TT * (DFF / 8); i += NGT) { const int m = i / (DFF / 8), j = (i % (DFF / 8)) * 8; const int t = m & (SEQ - 1);
        bf16_t* row = UP + (size_t)m * UPP;
        float g0[8], g1[8], g2[8], vv[8], w0[8], w1[8], w2[8], bb[8], o[8];
        unpack8(ldg16(row + j), g0); unpack8(ldg16(row + DFF + j), vv);
        if (t >= 1) unpack8(ldg16(row - UPP + j), g1); else {
#pragma unroll
            for (int e = 0; e < 8; ++e) g1[e] = 0.f; }
        if (t >= 2) unpack8(ldg16(row - 2 * UPP + j), g2); else {
#pragma unroll
            for (int e = 0; e < 8; ++e) g2[e] = 0.f; }
        ld8f(cw + j, w0); ld8f(cw + DFF + j, w1); ld8f(cw + 2 * DFF + j, w2); ld8f(cb + j, bb);
#pragma unroll
        for (int e = 0; e < 8; ++e) { const float cv = w0[e] * g2[e] + w1[e] * g1[e] + w2[e] * g0[e] + bb[e]; o[e] = siluf_(cv) * vv[e]; }
        *(u32x4*)(row + DFF + j) = pack8(o); }
}

__device__ __forceinline__ void la_phase(bf16_t* H, bf16_t* LA, bf16_t* KS, bf16_t* VF, const float* mu, const float* muv, int layer) {
    const int gt = obid() * NTHR + otid(), NGT = gridDim.x * NTHR;
    const int per_tok = layer ? 192 : 256;
    for (int i = gt; i < TT * per_tok; i += NGT) { const int m = i / per_tok, gi = i % per_tok; const int t = m & (SEQ - 1);
        int src = -1, mode = 0; const float* mup = mu; bf16_t* dst;
        if (gi < 64) { const int c = gi * 8; dst = LA + (size_t)m * 512 + c;
            if (c < 64) { src = HRW + 1536 + c; mup = mu + 1536 + c; mode = 1; }
            else if (c < 128) { src = HRW + 1600 + (c - 64); mup = mu + 1600 + (c - 64); }
            else if (c < 160) { if (layer) { src = HVL + (c - 128); mup = muv + (c - 128); } }
            else if (c >= 256 && c < 416) { src = HRW + 1664 + (c - 256); mup = mu + 1664 + (c - 256); mode = 2; }
        } else if (gi < 128) { const int c = (gi - 64) * 8; src = HRW + c; mup = mu + c; dst = H + (size_t)m * HP + C_RS + c; }
        else if (gi < 192) { const int c = (gi - 128) * 8; src = HRW + 512 + c; mup = mu + 512 + c; dst = KS + (size_t)m * 512 + c; }
        else { const int c = (gi - 192) * 8; src = HRW + 1024 + c; mup = mu + 1024 + c; dst = VF + (size_t)m * 512 + c; }
        float o[8];
        if (src < 0) {
#pragma unroll
            for (int e = 0; e < 8; ++e) o[e] = 0.f;
        } else {
            const bf16_t* hr = H + (size_t)m * HP + src; float cur[8], prv[8], m8[8];
            unpack8(ldg16(hr), cur); ld8f(mup, m8);
            if (t > 0) unpack8(ldg16(hr - HP), prv); else {
#pragma unroll
                for (int e = 0; e < 8; ++e) prv[e] = 0.f; }
#pragma unroll
            for (int e = 0; e < 8; ++e) { const float z = cur[e] + m8[e] * (prv[e] - cur[e]); o[e] = mode == 1 ? tanhf(z) : (mode == 2 ? sigmoidf_(z) : z); }
        }
        *(u32x4*)dst = pack8(o); }
}

__device__ __forceinline__ void post_phase(bf16_t* H, const bf16_t* VF, const float* stats, const float* bonus, const float* lnx_g, const float* lnx_b) {
    const int gt = obid() * NTHR + otid(), NGT = gridDim.x * NTHR;
    for (int i = gt; i < TT * 64; i += NGT) { const int m = i >> 6, c = (i & 63) * 8, hd = c >> 6;
        bf16_t* hr = H + (size_t)m * HP;
        float y[8], g[8], v[8], st[8], lg[8], lb[8], o[8];
        unpack8(ldg16(hr + C_Y + c), y); unpack8(ldg16(hr + C_G + c), g); unpack8(ldg16(VF + (size_t)m * 512 + c), v); ld8f(stats + ((size_t)m * 8 + hd) * 8, st); ld8f(lnx_g + c, lg); ld8f(lnx_b + c, lb);
        const float bon = bonus[(size_t)m * 8 + hd];
        const float mean = (st[0] + st[2] + st[4] + st[6]) * (1.0f / 64.0f); const float var = fmaxf((st[1] + st[3] + st[5] + st[7]) * (1.0f / 64.0f) - mean * mean, 0.f);
        const float rstd = rsqrtf(var + 64e-5f);
#pragma unroll
        for (int e = 0; e < 8; ++e) o[e] = ((y[e] - mean) * rstd * lg[e] + lb[e] + bon * v[e]) * g[e];
        *(u32x4*)(hr + C_Y + c) = pack8(o); }
}

__device__ __forceinline__ float tab_cos(unsigned u) { return (float)__builtin_bit_cast(_Float16, (unsigned short)(u & 0xffffu)); }
__device__ __forceinline__ float tab_sin(unsigned u) { return (float)__builtin_bit_cast(_Float16, (unsigned short)(u >> 16)); }
__device__ __forceinline__ void rot_pair(const u32x4 lo_raw, const u32x4 hi_raw, const u32x4 t0, const u32x4 t1, float scale, float (&lo)[8], float (&hi)[8]) {
    float a[8], b[8]; unpack8(lo_raw, a); unpack8(hi_raw, b);
    const unsigned tb[8] = {t0.x, t0.y, t0.z, t0.w, t1.x, t1.y, t1.z, t1.w};
#pragma unroll
    for (int e = 0; e < 8; ++e) { const float c = tab_cos(tb[e]), s = tab_sin(tb[e]); lo[e] = (a[e] * c - b[e] * s) * scale; hi[e] = (a[e] * s + b[e] * c) * scale; }
}
__device__ __forceinline__ void ret_state_phase(const bf16_t* H, bf16_t* RB, const unsigned* TAB, LAS unsigned char* lds) {
    const int tid = otid(), lane = tid & 63, wave = tid >> 6, fr = lane & 15, fq = lane >> 4;
    LAS bf16_t* KT = (LAS bf16_t*)lds;
    LAS bf16_t* VT = (LAS bf16_t*)(lds + 2 * 128 * 72 * 2);
    for (int u = obid(); u < 256; u += gridDim.x) {
        const int b = u >> 5, hh = (u >> 3) & 3, es = u & 7;
        const float log_g = __logf(1.0f - exp2f(-5.0f - (float)hh)); const float cdec = __expf(log_g * 64.0f);
        const int c = tid >> 3, dg = tid & 7, d0 = dg * 8;
        const float ksc = 0.08838834764831845f * __expf(log_g * (float)(63 - c));
        const bf16_t* kbase = H + (size_t)(b * SEQ + c) * HP + HK + hh * 128 + d0;
        const bf16_t* vbase = H + (size_t)(b * SEQ + (tid >> 1)) * HP + HV + hh * 128 + es * 16 + (tid & 1) * 8;
        const unsigned* tbase = TAB + (size_t)c * 64 + d0;
        u32x4 k_lo, k_hi, t0, t1, vr = (u32x4){0u, 0u, 0u, 0u};
        k_lo = ldg16(kbase); k_hi = ldg16(kbase + 64); t0 = ldg16(tbase); t1 = ldg16(tbase + 4); if (tid < 128) vr = ldg16(vbase);
        f32x4 acc = (f32x4){0.f, 0.f, 0.f, 0.f};
        bf16_t* rout = RB + ((size_t)((b * 4 + hh) * 64) * 128 + es * 16 + fr) * 128 + wave * 16 + 4 * fq;
        for (int n = 0; n < 64; ++n) {
            const int buf = n & 1; LAS bf16_t* kt = KT + buf * 128 * 72; LAS bf16_t* vt = VT + buf * 16 * 72;
            { float lo[8], hi[8]; rot_pair(k_lo, k_hi, t0, t1, ksc, lo, hi);
#pragma unroll
              for (int e = 0; e < 8; ++e) { kt[(d0 + e) * 72 + c] = f2bf1(lo[e]); kt[(64 + d0 + e) * 72 + c] = f2bf1(hi[e]); } }
            if (tid < 128) { const unsigned w4[4] = {vr.x, vr.y, vr.z, vr.w}; const int cc = tid >> 1, e0 = (tid & 1) * 8;
#pragma unroll
                for (int e = 0; e < 4; ++e) { vt[(e0 + 2 * e) * 72 + cc] = (bf16_t)(w4[e] & 0xffffu); vt[(e0 + 2 * e + 1) * 72 + cc] = (bf16_t)(w4[e] >> 16); } }
            if (n + 1 < 64) { const size_t adv = (size_t)(n + 1) * 64 * HP; k_lo = ldg16(kbase + adv); k_hi = ldg16(kbase + adv + 64); t0 = ldg16(tbase + (size_t)(n + 1) * 64 * 64); t1 = ldg16(tbase + (size_t)(n + 1) * 64 * 64 + 4); if (tid < 128) vr = ldg16(vbase + adv); }
            __syncthreads();
            { unsigned lo = cvt_pk_bf16(acc[0], acc[1]), hi = cvt_pk_bf16(acc[2], acc[3]); *(unsigned long long*)(rout + (size_t)n * 128 * 128) = (unsigned long long)lo | ((unsigned long long)hi << 32); }
            acc = acc * cdec;
#pragma unroll
            for (int ks = 0; ks < 2; ++ks) { const bf16x8 a = *(const LAS bf16x8*)(kt + (wave * 16 + fr) * 72 + ks * 32 + fq * 8); const bf16x8 bb = *(const LAS bf16x8*)(vt + fr * 72 + ks * 32 + fq * 8);
                acc = __builtin_amdgcn_mfma_f32_16x16x32_bf16(a, bb, acc, 0, 0, 0); }
        }
        __syncthreads();
    }
}
__device__ __forceinline__ void ret_out_phase(bf16_t* H, const bf16_t* RB, const unsigned* TAB, LAS unsigned char* lds) {
    const int tid = otid(), lane = tid & 63, wave = tid >> 6, fr = lane & 15, fq = lane >> 4;
    LAS bf16_t* Qs = (LAS bf16_t*)lds;
    LAS bf16_t* Ks = (LAS bf16_t*)(lds + 17408);
    LAS bf16_t* VT = (LAS bf16_t*)(lds + 34816);
    LAS bf16_t* Ps = (LAS bf16_t*)(lds + 34816 + 18432);
    LAS float* SS = (LAS float*)(lds + 34816 + 18432 + 9216);
    for (int u = obid(); u < 2048; u += gridDim.x) {
        const int n = u & 63, hh = (u >> 6) & 3, b = u >> 8;
        const float log_g = __logf(1.0f - exp2f(-5.0f - (float)hh));
        __syncthreads();
        {
            const int c = tid >> 3, dg = tid & 7, d0 = dg * 8; const size_t m = (size_t)b * SEQ + n * 64 + c;
            const bf16_t* hr = H + m * HP + hh * 128;
            const unsigned* tb = TAB + (size_t)(n * 64 + c) * 64 + d0; const u32x4 t0 = ldg16(tb), t1 = ldg16(tb + 4);
            float lo[8], hi[8];
            rot_pair(ldg16(hr + HQ + d0), ldg16(hr + HQ + 64 + d0), t0, t1, 1.0f, lo, hi);
            *(LAS u32x4*)(Qs + c * 136 + d0) = pack8(lo); *(LAS u32x4*)(Qs + c * 136 + 64 + d0) = pack8(hi);
            rot_pair(ldg16(hr + HK + d0), ldg16(hr + HK + 64 + d0), t0, t1, 0.08838834764831845f, lo, hi);
            *(LAS u32x4*)(Ks + c * 136 + d0) = pack8(lo); *(LAS u32x4*)(Ks + c * 136 + 64 + d0) = pack8(hi);
            const u32x4 v0 = ldg16(hr + HV + dg * 16), v1 = ldg16(hr + HV + dg * 16 + 8);
            const unsigned w8[8] = {v0.x, v0.y, v0.z, v0.w, v1.x, v1.y, v1.z, v1.w};
#pragma unroll
            for (int e = 0; e < 8; ++e) { VT[(dg * 16 + 2 * e) * 72 + c] = (bf16_t)(w8[e] & 0xffffu); VT[(dg * 16 + 2 * e + 1) * 72 + c] = (bf16_t)(w8[e] >> 16); }
        }
        bf16x8 rx[4];
        { const bf16_t* rb = RB + ((size_t)((b * 4 + hh) * 64 + n) * 128 + wave * 16 + fr) * 128 + fq * 8;
#pragma unroll
          for (int ks = 0; ks < 4; ++ks) rx[ks] = *(const bf16x8*)(rb + ks * 32); }
        __syncthreads();
        { const int mb = wave & 3, nb0 = 2 * (wave >> 2);
          f32x4 s0 = (f32x4){0.f, 0.f, 0.f, 0.f}, s1 = s0;
#pragma unroll
          for (int ks = 0; ks < 4; ++ks) { const bf16x8 a = *(const LAS bf16x8*)(Qs + (mb * 16 + fr) * 136 + ks * 32 + fq * 8);
              const bf16x8 b0 = *(const LAS bf16x8*)(Ks + (nb0 * 16 + fr) * 136 + ks * 32 + fq * 8), b1 = *(const LAS bf16x8*)(Ks + ((nb0 + 1) * 16 + fr) * 136 + ks * 32 + fq * 8);
              s0 = __builtin_amdgcn_mfma_f32_16x16x32_bf16(a, b0, s0, 0, 0, 0); s1 = __builtin_amdgcn_mfma_f32_16x16x32_bf16(a, b1, s1, 0, 0, 0); }
#pragma unroll
          for (int r = 0; r < 4; ++r) { const int cc = mb * 16 + 4 * fq + r; const int sA = nb0 * 16 + fr, sB = sA + 16;
              const float dA = __expf(log_g * fabsf((float)(cc - sA))), dB = __expf(log_g * fabsf((float)(cc - sB)));
              Ps[cc * 72 + sA] = f2bf1(s0[r] * dA); Ps[cc * 72 + sB] = f2bf1(s1[r] * dB); } }
        f32x4 o[4];
#pragma unroll
        for (int mb = 0; mb < 4; ++mb) { o[mb] = (f32x4){0.f, 0.f, 0.f, 0.f};
#pragma unroll
            for (int ks = 0; ks < 4; ++ks) { const bf16x8 a = *(const LAS bf16x8*)(Qs + (mb * 16 + fr) * 136 + ks * 32 + fq * 8); o[mb] = __builtin_amdgcn_mfma_f32_16x16x32_bf16(a, rx[ks], o[mb], 0, 0, 0); }
#pragma unroll
            for (int r = 0; r < 4; ++r) o[mb][r] *= __expf(log_g * (float)(mb * 16 + 4 * fq + r + 1)); }
        __syncthreads();
#pragma unroll
        for (int mb = 0; mb < 4; ++mb)
#pragma unroll
            for (int ks = 0; ks < 2; ++ks) { const bf16x8 a = *(const LAS bf16x8*)(Ps + (mb * 16 + fr) * 72 + ks * 32 + fq * 8); const bf16x8 bb = *(const LAS bf16x8*)(VT + (wave * 16 + fr) * 72 + ks * 32 + fq * 8);
                o[mb] = __builtin_amdgcn_mfma_f32_16x16x32_bf16(a, bb, o[mb], 0, 0, 0); }
#pragma unroll
        for (int mb = 0; mb < 4; ++mb)
#pragma unroll
            for (int r = 0; r < 4; ++r) { const float ss = row16_sum(o[mb][r] * o[mb][r]); if (fr == 0) SS[(mb * 16 + 4 * fq + r) * 8 + wave] = ss; }
        __syncthreads();
#pragma unroll
        for (int mb = 0; mb < 4; ++mb)
#pragma unroll
            for (int r = 0; r < 4; ++r) { const int cc = mb * 16 + 4 * fq + r; const f32x4 p0 = *(const LAS f32x4*)(SS + cc * 8), p1 = *(const LAS f32x4*)(SS + cc * 8 + 4);
                const float tot = (p0.x + p0.y) + (p0.z + p0.w) + (p1.x + p1.y) + (p1.z + p1.w); const float rinv = rsqrtf(tot * (1.0f / 128.0f) + 1e-6f);
                bf16_t* hr = H + ((size_t)b * SEQ + n * 64 + cc) * HP + hh * 128 + wave * 16 + fr;
                const float g = bflo((unsigned)hr[HG]);
                hr[C_RETIN] = f2bf1(o[mb][r] * rinv * siluf_(g)); }
    }
    __syncthreads();
}

__device__ __forceinline__ void scan_phase(bf16_t* H, const bf16_t* KS, bf16_t* VF, float* stats, float* bonus, const float* k_k, const float* k_a, const float* r_k, const float* muv, int layer, LAS unsigned char* lds) {
    const int tid = otid(), lane = tid & 63, wave = tid >> 6;
    LAS float* PB = (LAS float*)lds;
    LAS float* VB = (LAS float*)(lds + 81920);
    LAS float* SC = (LAS float*)(lds + 81920 + 4096);
    LAS float* YB = (LAS float*)(lds + 81920 + 4096 + 512);
    for (int u = obid(); u < 256; u += gridDim.x) {
        const int bh = u >> 2, part = u & 3, b = bh >> 3, hd = bh & 7, i0 = part * 16;
        __syncthreads();
        if (wave >= 4) {
            const int hid = tid - 256, t = hid >> 3, jg = hid & 7, col = hd * 64 + jg * 8;
            float kk8[8], ka8[8], rk8[8]; ld8f(k_k + col, kk8); ld8f(k_a + col, ka8); ld8f(r_k + col, rk8);
            for (int c = -1; c <= 128; ++c) {
                if (c >= 1) {
                    const int ob = (c - 1) & 1; const size_t m = (size_t)b * SEQ + (c - 1) * 32 + t;
                    const float y0 = YB[(ob * 32 + t) * 16 + 2 * jg], y1 = YB[(ob * 32 + t) * 16 + 2 * jg + 1];
                    *(unsigned*)(H + m * HP + C_Y + hd * 64 + i0 + 2 * jg) = cvt_pk_bf16(y0, y1);
                    float s = y0 + y1, q = y0 * y0 + y1 * y1;
                    s += __shfl_xor(s, 1); q += __shfl_xor(q, 1); s += __shfl_xor(s, 2); q += __shfl_xor(q, 2); s += __shfl_xor(s, 4); q += __shfl_xor(q, 4);
                    if (jg == 0) { float* sp = stats + ((m * 8 + hd) * 4 + part) * 2; sp[0] = s; sp[1] = q; }
                }
                if (c + 1 < 128) {
                    const int nb = (c + 1) & 1; const size_t m = (size_t)b * SEQ + (c + 1) * 32 + t;
                    const bf16_t* hr = H + m * HP + col;
                    float r8[8], l8[8], a8[8], k8[8];
                    unpack8(ldg16(hr + C_RS), r8); unpack8(ldg16(hr + C_LD), l8); unpack8(ldg16(hr + C_AA), a8); unpack8(ldg16(KS + m * 512 + col), k8);
                    float kkv[8], ssq = 0.f;
#pragma unroll
                    for (int e = 0; e < 8; ++e) { kkv[e] = k8[e] * kk8[e]; ssq += kkv[e] * kkv[e]; }
                    ssq += __shfl_xor(ssq, 1); ssq += __shfl_xor(ssq, 2); ssq += __shfl_xor(ssq, 4);
                    const float inv = 1.0f / fmaxf(sqrtf(ssq), 1e-12f);
                    float na[8], wr[8], w[8], bb[8], kt[8]; float br = 0.f, kr = 0.f, bo = 0.f;
#pragma unroll
                    for (int e = 0; e < 8; ++e) { const float kn = kkv[e] * inv; w[e] = __expf(l8[e]); kt[e] = k8[e] * (1.0f + (a8[e] - 1.0f) * ka8[e]); bb[e] = kn * a8[e]; na[e] = -kn; wr[e] = w[e] * r8[e];
                        br += bb[e] * r8[e]; kr += kt[e] * r8[e]; bo += r8[e] * kt[e] * rk8[e]; }
                    br += __shfl_xor(br, 1); kr += __shfl_xor(kr, 1); bo += __shfl_xor(bo, 1); br += __shfl_xor(br, 2); kr += __shfl_xor(kr, 2); bo += __shfl_xor(bo, 2); br += __shfl_xor(br, 4); kr += __shfl_xor(kr, 4); bo += __shfl_xor(bo, 4);
                    LAS float* pb = PB + ((nb * 32 + t) * 16 + 2 * jg) * 20;
#pragma unroll
                    for (int h2 = 0; h2 < 2; ++h2) { LAS f32x4* q4 = (LAS f32x4*)(pb + h2 * 20);
                        q4[0] = (f32x4){na[4 * h2], na[4 * h2 + 1], na[4 * h2 + 2], na[4 * h2 + 3]}; q4[1] = (f32x4){wr[4 * h2], wr[4 * h2 + 1], wr[4 * h2 + 2], wr[4 * h2 + 3]};
                        q4[2] = (f32x4){w[4 * h2], w[4 * h2 + 1], w[4 * h2 + 2], w[4 * h2 + 3]}; q4[3] = (f32x4){bb[4 * h2], bb[4 * h2 + 1], bb[4 * h2 + 2], bb[4 * h2 + 3]};
                        q4[4] = (f32x4){kt[4 * h2], kt[4 * h2 + 1], kt[4 * h2 + 2], kt[4 * h2 + 3]}; }
                    if (jg < 2) { float v8[8]; const int vc = hd * 64 + i0 + jg * 8; unpack8(ldg16(VF + m * 512 + vc), v8);
                        if (layer) { float cur[8], prv[8], sg[8], m8[8]; const bf16_t* hv = H + m * HP; unpack8(ldg16(hv + HRW + 1024 + vc), cur); unpack8(ldg16(hv + C_Y + vc), sg); ld8f(muv + vc, m8);
                            if ((c + 1) * 32 + t > 0) unpack8(ldg16(hv - HP + HRW + 1024 + vc), prv); else {
#pragma unroll
                                for (int e = 0; e < 8; ++e) prv[e] = 0.f; }
#pragma unroll
                            for (int e = 0; e < 8; ++e) { const float z = cur[e] + m8[e] * (prv[e] - cur[e]); v8[e] = z + (v8[e] - z) * sg[e]; }
                            *(u32x4*)(VF + m * 512 + vc) = pack8(v8); unpack8(pack8(v8), v8); }
                        LAS f32x4* vp = (LAS f32x4*)(VB + (nb * 32 + t) * 16 + jg * 8);
                        vp[0] = (f32x4){v8[0], v8[1], v8[2], v8[3]}; vp[1] = (f32x4){v8[4], v8[5], v8[6], v8[7]}; }
                    if (jg == 0) { SC[(nb * 32 + t) * 2] = br; SC[(nb * 32 + t) * 2 + 1] = kr; if (part == 0) bonus[m * 8 + hd] = bo; }
                }
                if (c < 128) __syncthreads();
            }
        } else {
            const int il = wave * 4 + (lane >> 4), q = lane & 15;
            f32x4 s = (f32x4){0.f, 0.f, 0.f, 0.f};
            __syncthreads();
            for (int c = 0; c < 128; ++c) {
                const int buf = c & 1; const LAS float* pb = PB + (buf * 32 * 16 + q) * 20; const LAS float* vb = VB + buf * 32 * 16 + il; const LAS float* sc = SC + buf * 64; LAS float* yb = YB + buf * 32 * 16 + il;
#pragma unroll 4
                for (int t = 0; t < 32; ++t) {
                    const LAS f32x4* p4 = (const LAS f32x4*)(pb + t * 320);
                    const f32x4 na = p4[0], wr = p4[1], w = p4[2], bb = p4[3], kt = p4[4];
                    const float vi = vb[t * 16]; const float br = sc[2 * t], kr = sc[2 * t + 1];
                    float pa = (s.x * na.x + s.y * na.y) + (s.z * na.z + s.w * na.w);
                    float py = (s.x * wr.x + s.y * wr.y) + (s.z * wr.z + s.w * wr.w);
                    const f32x4 uu = kt * vi;
                    const float sa = row16_sum(pa), sy = row16_sum(py);
                    s = s * w + (bb * sa + uu);
                    if (q == 0) yb[t * 16] = sy + sa * br + vi * kr;
                }
                __syncthreads();
            }
        }
    }
    __syncthreads();
}

constexpr int PT_OFF = 131072;
__device__ __forceinline__ const float* gin(LAS unsigned char* lds, int i) { const unsigned long long v = ((volatile LAS unsigned long long*)(lds + PT_OFF))[i];
    const unsigned lo = __builtin_amdgcn_readfirstlane((unsigned)v), hi = __builtin_amdgcn_readfirstlane((unsigned)(v >> 32)); return (const float*)(((unsigned long long)hi << 32) | lo); }
__global__ void __launch_bounds__(NTHR) mega_fwd(Params p) {
    extern __shared__ __attribute__((aligned(16))) unsigned char lds_raw[];
    LAS unsigned char* lds = (LAS unsigned char*)lds_raw;
    cg::grid_group grid = cg::this_grid();
    if (threadIdx.x == 0) { volatile LAS unsigned long long* PT = (volatile LAS unsigned long long*)(lds + PT_OFF);
#pragma unroll
        for (int i = 0; i < 28; ++i) PT[i] = (unsigned long long)p.in[i];
        PT[28] = (unsigned long long)p.out; PT[29] = (unsigned long long)p.ws; }
    __syncthreads();
#define WSP ((unsigned char*)gin(lds, 29))
#define OUTP ((float*)gin(lds, 28))
#define P_TAB ((unsigned*)(WSP + OFF_TAB))
#define P_BONUS ((float*)(WSP + OFF_BONUS))
#define P_STATS ((float*)(WSP + OFF_STATS))
#define P_WB ((bf16_t*)(WSP + OFF_W))
#define P_VF ((bf16_t*)(WSP + OFF_VF))
#define P_XB ((bf16_t*)(WSP + OFF_XB))
#define P_H ((bf16_t*)(WSP + OFF_H))
#define P_KS (P_XB + (size_t)TT * 512)


#ifndef NO_W
        weights_phase(lds, 0);
#endif

#ifndef NO_X
        x_phase(gin(lds, 0), WSP);
#endif

    grid.sync();
#pragma unroll 1
    for (int l = 0; l < 2; ++l) {

#ifndef NO_G1
        { EpiStore E{lds, HP, 5920 + 32 * l, 0}; run_gemm(lds, P_XB, 1024, P_WB + W_WIN, 6144, 1024, E); }
#endif

        grid.sync();

#ifndef NO_RS
        ret_state_phase(P_H, P_XB, P_TAB, lds);
#endif

        grid.sync();

#ifndef NO_RO
        ret_out_phase(P_H, P_XB, P_TAB, lds);
#endif

        grid.sync();

#ifndef NO_LA
        la_phase(P_H, P_XB, P_KS, P_VF, gin(lds, 2) + l * 1824, gin(lds, 4), l);
#endif

        grid.sync();

#ifndef NO_G5
        { EpiLora E{lds, l}; run_gemm(lds, P_XB, 512, P_WB + W_LORA, 1536, 256, E); }
#endif

#ifndef NO_G7
        { EpiStore E{lds, HP, 512, C_G}; run_gemm(lds, P_XB + 256, 512, P_WB + W_G2T, 512, 256, E); }
#endif

        grid.sync();

#ifndef NO_SCAN
        scan_phase(P_H, P_KS, P_VF, P_STATS, P_BONUS, gin(lds, 12) + l * 512, gin(lds, 13) + l * 512, gin(lds, 14) + l * 512, gin(lds, 2) + l * 1824 + 1024, l, lds);
#endif

        grid.sync();

#ifndef NO_POST
        post_phase(P_H, P_VF, P_STATS, P_BONUS, gin(lds, 15) + l * 512, gin(lds, 16) + l * 512);
#endif

        grid.sync();

#ifndef NO_G8
        { EpiMerge E{lds, HGA, 0}; run_gemm(lds, P_H + C_RETIN, HP, P_WB + W_RETO, 1024, 512, E); }
#endif


#ifndef NO_G9
        { EpiMerge E{lds, HGB, 1}; run_gemm(lds, P_H + C_Y, HP, P_WB + W_RWKVO, 1024, 512, E); }
#endif

        grid.sync();

#ifndef NO_G10
        { EpiResid E{lds, l == 0 ? 1 : 0}; run_gemm(lds, P_XB, 1024, P_WB + W_WOUT, 1024, 1024, E); }
#endif

        grid.sync();

#ifndef NO_LN1
        ln_phase(OUTP, gin(lds, 20) + l * 1024, gin(lds, 21) + l * 1024, P_XB);
#endif

        grid.sync();

#ifndef NO_G12
        { EpiStore E{lds, UPP, UPP, 0}; run_gemm(lds, P_XB, 1024, P_WB + W_WUP, UPP, 1024, E); }
#endif

        grid.sync();

#ifndef NO_ACT
        act_phase(P_H, gin(lds, 23) + (size_t)l * 3 * DFF, gin(lds, 24) + (size_t)l * DFF);
#endif

        grid.sync();

#ifndef NO_G14
        { EpiResid E{lds, 0}; run_gemm(lds, P_H + DFF, UPP, P_WB + W_WDOWN, 1024, DFF, E); }
#endif

        grid.sync();

#ifndef NO_LN2
        ln_phase(OUTP, gin(lds, 26) + l * 1024, gin(lds, 27) + l * 1024, l == 0 ? P_XB : (bf16_t*)nullptr);
#endif

        if (l == 0) {
#ifndef NO_W1
        weights_phase(lds, 1);
#endif
 grid.sync(); }
    }
}

extern "C" void kernel_launch(void* const* d_in, const int* in_sizes, int n_in, void* d_out, int out_size, void* d_ws, size_t ws_size, hipStream_t stream) {
    static int grid = 0;
    if (grid == 0) {
        if (n_in != 28 || ws_size < WS_END) { fprintf(stderr, "kernel_launch: unexpected n_in %d or ws_size %zu (need %zu)\n", n_in, ws_size, (size_t)WS_END); grid = -1; return; }
        int dev = 0, cus = 0, per_cu = 0;
        hipGetDevice(&dev); hipDeviceGetAttribute(&cus, hipDeviceAttributeMultiprocessorCount, dev);
        hipFuncSetAttribute((const void*)mega_fwd, hipFuncAttributeMaxDynamicSharedMemorySize, LDS_BYTES);
        hipOccupancyMaxActiveBlocksPerMultiprocessor(&per_cu, (const void*)mega_fwd, NTHR, LDS_BYTES);
        if (per_cu < 1) { fprintf(stderr, "kernel_launch: occupancy query says %d blocks/CU\n", per_cu); grid = -1; return; }
        grid = cus;
    }
    if (grid < 0) return;
    Params p{};
    for (int i = 0; i < 28; ++i) p.in[i] = (const float*)d_in[i];
    p.out = (float*)d_out; p.ws = (unsigned char*)d_ws;
    void* args[] = {&p};
    hipError_t e = hipLaunchCooperativeKernel((const void*)mega_fwd, dim3(grid), dim3(NTHR), args, LDS_BYTES, stream);
    if (e != hipSuccess) fprintf(stderr, "cooperative launch failed: %s (grid %d)\n", hipGetErrorString(e), grid);
}
```

```cpp
#include <hip/hip_runtime.h>
#include <hip/hip_cooperative_groups.h>
#include <cstdio>
#include <cstdint>
namespace cg = cooperative_groups;
namespace pg8 {
#define PG8_LAS __attribute__((address_space(3)))
typedef unsigned short bf16_t;
typedef short bf16x8 __attribute__((ext_vector_type(8)));
typedef float f32x4 __attribute__((ext_vector_type(4)));
typedef unsigned u32x4 __attribute__((ext_vector_type(4)));
constexpr int BM = 256, BK = 64, HALF = 128, HTB = HALF * BK * 2  , STAGE_BYTES = 8 * HTB, NXCD = 8, WGM = 8;

__host__ __device__ __forceinline__ int lds_byte(int r, int c) { const int st = (r >> 4) * 2 + (c >> 5), rr = r & 15, cc = c & 31, ob = rr * 64 + cc * 2; return st * 1024 + (ob ^ (((ob >> 9) & 1) << 5)); }
__host__ __device__ __forceinline__ void stage_rc(int b, int& R, int& C) { const int st = b / 1024, sb = b % 1024, swz = sb ^ (((sb >> 9) & 1) << 5); R = (st >> 1) * 16 + swz / 64; C = (st & 1) * 32 + (swz % 64) / 2; }
__host__ __device__ __forceinline__ int perm32(int rho) { const int n = rho >> 4, i = rho & 15; return 8 * (i >> 2) + 4 * n + (i & 3); }

struct Unit { int pm, pn; };
struct Gemm { const bf16_t* A; const bf16_t* Bt; int M, N, K, lda; };

struct StaticOrder {
    int nM, nN, nwg, G, c;
    __host__ __device__ void init(int M, int N, int G_, int c_) { nM = M / BM; nN = N / BM; nwg = nM * nN; G = G_; c = c_; }
    __host__ __device__ bool next(int i, Unit& u) const {
        const long L = (long)i * G + c; if (L >= nwg) return false;
        int wgid = (int)L; { const int q = nwg / NXCD, r = nwg % NXCD, xcd = wgid % NXCD, off = wgid / NXCD; wgid = (xcd < r ? xcd * (q + 1) : r * (q + 1) + (xcd - r) * q) + off; }
        const int nig = WGM * nN, gid = wgid / nig, fm = gid * WGM, gsz = (nM - fm) < WGM ? (nM - fm) : WGM;
        u.pm = fm + ((wgid % nig) % gsz); u.pn = (wgid % nig) / gsz; return true;
    }
    __device__ __forceinline__ void a_ready(const Unit&) const {}
    __device__ __forceinline__ void done(const Unit&) const {}
};

__device__ __forceinline__ unsigned cvt_pk_bf16(float lo, float hi) { unsigned r; asm volatile("v_cvt_pk_bf16_f32 %0, %1, %2" : "=v"(r) : "v"(lo), "v"(hi)); return r; }
typedef float f32x2 __attribute__((ext_vector_type(2)));

template <class Epi, class Sched, bool ALIGN_EPI = false, bool SP2 = false>
__device__ __forceinline__ void gemm_phase(PG8_LAS unsigned char* lds, const Gemm g, const Sched& S, const Epi& E) {
    int tid = threadIdx.x; asm volatile("" : "+v"(tid)); const int wid = __builtin_amdgcn_readfirstlane(tid >> 6), lane = tid & 63, wr = wid >> 2, wc = wid & 3, fr = lane & 15, fq = lane >> 4;
    const int K = g.K, nt = K / BK;
    unsigned voffA[2], voffB[2];
#pragma unroll
    for (int i = 0; i < 2; ++i) { int R, C; stage_rc(tid * 16 + i * 8192, R, C); const int Rb = Epi::PERM ? ((R & ~31) + perm32(R & 31)) : R;
        voffA[i] = (unsigned)(R * g.lda + C) * 2u; voffB[i] = (unsigned)(Rb * K + C) * 2u; }
    const size_t kstep = (size_t)(BK * 2);
    const size_t hstepA = (size_t)HALF * g.lda * 2, hstepB = (size_t)HALF * K * 2;
    const size_t tstepA = 2 * hstepA, tstepB = 2 * hstepB;
    const unsigned ldsw = (unsigned)wid * 1024u;
    const int aoff = lds_byte(wr * 64 + fr, fq * 8), boff = lds_byte(wc * 32 + fr, fq * 8);
#define PG8_SA(b, h) (((b) * 2 + (h)) * HTB)
#define PG8_SB(b, h) ((4 + (b) * 2 + (h)) * HTB)
#define PG8_STAGE(bufoff, gbase, voff) do { _Pragma("unroll") for (int _i = 0; _i < 2; ++_i) \
        __builtin_amdgcn_global_load_lds((const unsigned*)((const char*)(gbase) + (voff)[_i]), (PG8_LAS unsigned*)(lds + (bufoff) + ldsw + _i * 8192), 16, 0, 0); } while (0)
#define PG8_LDA(dst, b, h) do { _Pragma("unroll") for (int m = 0; m < 4; ++m) _Pragma("unroll") for (int k = 0; k < 2; ++k) dst[m][k] = *(const PG8_LAS bf16x8*)(lds + PG8_SA(b, h) + aoff + m * 2048 + k * 1024); } while (0)
#define PG8_LDB(dst, b, h) do { _Pragma("unroll") for (int n = 0; n < 2; ++n) _Pragma("unroll") for (int k = 0; k < 2; ++k) dst[n][k] = *(const PG8_LAS bf16x8*)(lds + PG8_SB(b, h) + boff + n * 2048 + k * 1024); } while (0)
#define PG8_MMA(ai, bj, At, Bt) do { __builtin_amdgcn_s_setprio(1); _Pragma("unroll") for (int m = 0; m < 4; ++m) _Pragma("unroll") for (int n = 0; n < 2; ++n) _Pragma("unroll") for (int k = 0; k < 2; ++k) \
        acc[ai][bj][m][n] = __builtin_amdgcn_mfma_f32_16x16x32_bf16(Bt[n][k], At[m][k], acc[ai][bj][m][n], 0, 0, 0); __builtin_amdgcn_s_setprio(0); } while (0)
#define PG8_WAIT_V(n) asm volatile("s_waitcnt vmcnt(" #n ")" ::: "memory")
#define PG8_WAIT_L(n) asm volatile("s_waitcnt lgkmcnt(" #n ")" ::: "memory")
#define PG8_BAR __builtin_amdgcn_s_barrier()
#define PG8_SCHED __builtin_amdgcn_sched_barrier(0)
    Unit cur, nxt; int ui = 0;
    if (!S.next(0, cur)) return;
    f32x4 acc[2][2][4][2];
#pragma unroll
    for (int a = 0; a < 2; ++a)
#pragma unroll
        for (int b = 0; b < 2; ++b)
#pragma unroll
            for (int m = 0; m < 4; ++m)
#pragma unroll
                for (int n = 0; n < 2; ++n) acc[a][b][m][n] = (f32x4){0.f, 0.f, 0.f, 0.f};
    bf16x8 At[4][2], B0[2][2], B1[2][2];
    const char* cA = (const char*)g.A + (size_t)cur.pm * tstepA; const char* cB = (const char*)g.Bt + (size_t)cur.pn * tstepB;
    S.a_ready(cur);
    if constexpr (SP2) {
        PG8_STAGE(PG8_SB(0, 0), cB, voffB); PG8_STAGE(PG8_SB(0, 1), cB + hstepB, voffB); PG8_STAGE(PG8_SA(0, 0), cA, voffA); PG8_STAGE(PG8_SA(0, 1), cA + hstepA, voffA);
        if (wr == 1) PG8_BAR;
        PG8_WAIT_V(2); PG8_BAR;
        PG8_STAGE(PG8_SB(1, 0), cB + kstep, voffB); PG8_STAGE(PG8_SA(1, 0), cA + kstep, voffA); PG8_STAGE(PG8_SB(1, 1), cB + hstepB + kstep, voffB);
        PG8_WAIT_V(6); PG8_BAR;
    } else {
        PG8_STAGE(PG8_SB(0, 0), cB, voffB); PG8_STAGE(PG8_SA(0, 0), cA, voffA); PG8_STAGE(PG8_SB(0, 1), cB + hstepB, voffB); PG8_STAGE(PG8_SA(0, 1), cA + hstepA, voffA);
        if (wr == 1) PG8_BAR;
        PG8_WAIT_V(4); PG8_BAR;
        PG8_STAGE(PG8_SB(1, 0), cB + kstep, voffB); PG8_STAGE(PG8_SA(1, 0), cA + kstep, voffA); PG8_STAGE(PG8_SB(1, 1), cB + hstepB + kstep, voffB);
        PG8_WAIT_V(6); PG8_BAR;
    }
    for (;;) {
        const bool has_next = S.next(ui + 1, nxt);
        const char* nA = has_next ? (const char*)g.A + (size_t)nxt.pm * tstepA : cA; const char* nB = has_next ? (const char*)g.Bt + (size_t)nxt.pn * tstepB : cB;
        for (int t = 0; t < nt; t += 2) {
            const bool last = (t == nt - 2);
            const char* a1 = cA + (size_t)(t + 1) * kstep;
            const char* a2 = last ? nA : cA + (size_t)(t + 2) * kstep; const char* b2 = last ? nB : cB + (size_t)(t + 2) * kstep;
            const char* a3 = a2 + kstep; const char* b3 = b2 + kstep;
            if (last && has_next) S.a_ready(nxt);
            if constexpr (SP2) {
            PG8_LDB(B0, 0, 0); PG8_LDB(B1, 0, 1); PG8_SCHED; PG8_LDA(At, 0, 0); PG8_STAGE(PG8_SA(1, 1), a1 + hstepA, voffA);
            PG8_WAIT_V(8); PG8_WAIT_L(0); PG8_BAR; PG8_MMA(0, 0, At, B0); PG8_MMA(0, 1, At, B1); PG8_BAR; PG8_SCHED;
            PG8_LDA(At, 0, 1); PG8_STAGE(PG8_SB(0, 0), b2, voffB); PG8_STAGE(PG8_SB(0, 1), b2 + hstepB, voffB); PG8_STAGE(PG8_SA(0, 0), a2, voffA);
            PG8_WAIT_V(8); PG8_WAIT_L(0); PG8_BAR; PG8_MMA(1, 0, At, B0); PG8_MMA(1, 1, At, B1); PG8_BAR; PG8_SCHED;
            PG8_LDB(B0, 1, 0); PG8_LDB(B1, 1, 1); PG8_SCHED; PG8_LDA(At, 1, 0); PG8_STAGE(PG8_SA(0, 1), a2 + hstepA, voffA);
            PG8_WAIT_V(8); PG8_WAIT_L(0); PG8_BAR; PG8_MMA(0, 0, At, B0); PG8_MMA(0, 1, At, B1); PG8_BAR; PG8_SCHED;
            PG8_LDA(At, 1, 1); PG8_STAGE(PG8_SB(1, 0), b3, voffB); PG8_STAGE(PG8_SB(1, 1), b3 + hstepB, voffB); PG8_STAGE(PG8_SA(1, 0), a3, voffA);
            PG8_WAIT_V(8); PG8_WAIT_L(0); PG8_BAR; PG8_MMA(1, 0, At, B0); PG8_MMA(1, 1, At, B1); PG8_BAR; PG8_SCHED;
            } else {
            PG8_LDB(B0, 0, 0); PG8_SCHED; PG8_LDA(At, 0, 0); PG8_STAGE(PG8_SA(1, 1), a1 + hstepA, voffA);
            PG8_WAIT_L(8); PG8_BAR; PG8_WAIT_L(0); PG8_MMA(0, 0, At, B0); PG8_BAR; PG8_SCHED;
            PG8_LDB(B1, 0, 1); PG8_STAGE(PG8_SB(0, 0), b2, voffB);
            PG8_BAR; PG8_WAIT_L(0); PG8_MMA(0, 1, At, B1); PG8_BAR;
            PG8_LDA(At, 0, 1); PG8_STAGE(PG8_SA(0, 0), a2, voffA);
            PG8_BAR; PG8_WAIT_L(0); PG8_MMA(1, 0, At, B0); PG8_BAR; PG8_SCHED;
            PG8_STAGE(PG8_SB(0, 1), b2 + hstepB, voffB);
            PG8_WAIT_V(6); PG8_BAR; PG8_MMA(1, 1, At, B1); PG8_BAR;
            PG8_LDB(B0, 1, 0); PG8_SCHED; PG8_LDA(At, 1, 0); PG8_STAGE(PG8_SA(0, 1), a2 + hstepA, voffA);
            PG8_WAIT_L(8); PG8_BAR; PG8_WAIT_L(0); PG8_MMA(0, 0, At, B0); PG8_BAR; PG8_SCHED;
            PG8_LDB(B1, 1, 1); PG8_STAGE(PG8_SB(1, 0), b3, voffB);
            PG8_BAR; PG8_WAIT_L(0); PG8_MMA(0, 1, At, B1); PG8_BAR;
            PG8_LDA(At, 1, 1); PG8_STAGE(PG8_SA(1, 0), a3, voffA);
            PG8_BAR; PG8_WAIT_L(0); PG8_MMA(1, 0, At, B0); PG8_BAR; PG8_SCHED;
            PG8_STAGE(PG8_SB(1, 1), b3 + hstepB, voffB);
            PG8_WAIT_V(6); PG8_BAR; PG8_MMA(1, 1, At, B1); PG8_BAR;
            }
        }
        if constexpr (ALIGN_EPI) { if (wr == 0) PG8_BAR; }
        if constexpr (!Epi::AFTER_DRAIN) { E(acc, cur, wr, wc, fr, fq); S.done(cur); }
        if (!has_next) break;
#pragma unroll
        for (int a = 0; a < 2; ++a)
#pragma unroll
            for (int b = 0; b < 2; ++b)
#pragma unroll
                for (int m = 0; m < 4; ++m)
#pragma unroll
                    for (int n = 0; n < 2; ++n) acc[a][b][m][n] = (f32x4){0.f, 0.f, 0.f, 0.f};
        cur = nxt; cA = nA; cB = nB; ++ui;
        if constexpr (ALIGN_EPI) { if (wr == 1) PG8_BAR; }
    }
    PG8_WAIT_V(0);
    if constexpr (!ALIGN_EPI) { if (wr == 0) PG8_BAR; }
    PG8_BAR;
    if constexpr (Epi::AFTER_DRAIN) { E.fused(acc, cur, wr, wc, fr, fq, lds, wid, lane); S.done(cur); }
#undef PG8_SA
#undef PG8_SB
#undef PG8_STAGE
#undef PG8_LDA
#undef PG8_LDB
#undef PG8_MMA
#undef PG8_WAIT_V
#undef PG8_WAIT_L
#undef PG8_BAR
#undef PG8_SCHED
}
}

using pg8::bf16_t; using pg8::f32x4; using pg8::bf16x8; using pg8::u32x4; using pg8::cvt_pk_bf16;
#define LAS __attribute__((address_space(3)))
constexpr int NTHR = 512;
constexpr int TT = 32768, SEQ = 4096, DM = 1024, HP = 5952, UPP = 5632, DFF = 2816;
constexpr int HQ = 0, HK = 512, HV = 1024, HG = 1536, HRW = 2048, HGA = 3872, HGB = 4896, HVL = 5920;
constexpr int C_RETIN = HQ, C_RS = HK, C_LD = HV, C_AA = HG, C_Y = HRW, C_G = HRW + 512;
constexpr float ALPHA = 1.4142135623730951f;
constexpr size_t OFF_TAB = 65536, OFF_BONUS = OFF_TAB + 1048576, OFF_STATS = OFF_BONUS + 1048576, OFF_W = OFF_STATS + 8388608;
constexpr size_t W_WIN = 0, W_LORA = 6291456, W_G2T = 6684672, W_RETO = 6815744, W_RWKVO = 7340032, W_WOUT = 7864320, W_WUP = 8912896, W_WDOWN = 14680064, W_END = 17563648;
constexpr size_t OFF_VF = OFF_W + W_END * 2, OFF_XB = OFF_VF + (size_t)TT * 512 * 2, OFF_H = OFF_XB + (size_t)TT * 1024 * 2, WS_END = OFF_H + (size_t)TT * HP * 2;
static_assert(WS_END <= 536870912ull, "workspace map");
constexpr int LDS_BYTES = 147456;

struct Params { const float* in[28]; float* out; unsigned char* ws; };
__device__ __forceinline__ int obid() { int t = blockIdx.x; asm volatile("" : "+s"(t)); return t; }
__device__ __forceinline__ int otid() { int t = threadIdx.x; asm volatile("" : "+v"(t)); return t; }

__device__ __forceinline__ float bflo(unsigned u) { return __uint_as_float(u << 16); }
__device__ __forceinline__ float bfhi(unsigned u) { return __uint_as_float(u & 0xffff0000u); }
__device__ __forceinline__ void unpack8(const u32x4 v, float (&f)[8]) { f[0] = bflo(v.x); f[1] = bfhi(v.x); f[2] = bflo(v.y); f[3] = bfhi(v.y); f[4] = bflo(v.z); f[5] = bfhi(v.z); f[6] = bflo(v.w); f[7] = bfhi(v.w); }
__device__ __forceinline__ u32x4 pack8(const float (&f)[8]) { u32x4 w; w.x = cvt_pk_bf16(f[0], f[1]); w.y = cvt_pk_bf16(f[2], f[3]); w.z = cvt_pk_bf16(f[4], f[5]); w.w = cvt_pk_bf16(f[6], f[7]); return w; }
__device__ __forceinline__ u32x4 ldg16(const void* p) { return *(const u32x4*)p; }
__device__ __forceinline__ void ld8f(const float* p, float (&f)[8]) { const f32x4 a = *(const f32x4*)p, b = *(const f32x4*)(p + 4); f[0] = a.x; f[1] = a.y; f[2] = a.z; f[3] = a.w; f[4] = b.x; f[5] = b.y; f[6] = b.z; f[7] = b.w; }
__device__ __forceinline__ unsigned short f2bf1(float f) { return (unsigned short)(cvt_pk_bf16(f, 0.f) & 0xffffu); }
__device__ __forceinline__ float sigmoidf_(float x) { return 1.0f / (1.0f + __expf(-x)); }
__device__ __forceinline__ float siluf_(float x) { return x / (1.0f + __expf(-x)); }
template <int N> __device__ __forceinline__ float dpp_ror(float v) { return __builtin_bit_cast(float, __builtin_amdgcn_update_dpp(0, __builtin_bit_cast(int, v), 0x120 + N, 0xf, 0xf, false)); }
__device__ __forceinline__ float row16_sum(float v) { v += dpp_ror<8>(v); v += dpp_ror<4>(v); v += dpp_ror<2>(v); v += dpp_ror<1>(v); return v; }
__device__ __forceinline__ float wave_sum(float v) {
#pragma unroll
    for (int o = 1; o < 64; o <<= 1) v += __shfl_xor(v, o);
    return v;
}

__device__ __forceinline__ const float* gin(LAS unsigned char* lds, int i);
struct EpiStore {
    static constexpr bool PERM = true, AFTER_DRAIN = false;
    LAS unsigned char* lds; int ldc; int nvalid; int coff;
    __device__ __forceinline__ void operator()(const f32x4 (&acc)[2][2][4][2], const pg8::Unit& u, int wr, int wc, int fr, int fq) const {
        asm volatile("" : "+v"(fr), "+v"(fq), "+s"(wr), "+s"(wc));
        const int row0 = u.pm * 256 + wr * 64 + fr, col0 = u.pn * 256 + wc * 32 + 8 * fq;
        bf16_t* O = (bf16_t*)((unsigned char*)gin(lds, 29) + OFF_H) + coff;
#pragma unroll
        for (int ai = 0; ai < 2; ++ai)
#pragma unroll
            for (int m = 0; m < 4; ++m) { bf16_t* rowp = O + (size_t)(row0 + ai * 128 + m * 16) * ldc + col0;
#pragma unroll
                for (int bj = 0; bj < 2; ++bj) { const f32x4 v0 = acc[ai][bj][m][0], v1 = acc[ai][bj][m][1];
                    u32x4 w; w.x = cvt_pk_bf16(v0[0], v0[1]); w.y = cvt_pk_bf16(v0[2], v0[3]); w.z = cvt_pk_bf16(v1[0], v1[1]); w.w = cvt_pk_bf16(v1[2], v1[3]);
                    if (col0 + bj * 128 < nvalid) *(u32x4*)(rowp + bj * 128) = w; } }
    }
};
struct EpiLora {
    static constexpr bool PERM = true, AFTER_DRAIN = false;
    LAS unsigned char* lds; int layer;
    __device__ __forceinline__ void operator()(const f32x4 (&acc)[2][2][4][2], const pg8::Unit& u, int wr, int wc, int fr, int fq) const {
        asm volatile("" : "+v"(fr), "+v"(fq), "+s"(wr), "+s"(wc));
        const int kind = u.pn >> 1; const int row0 = u.pm * 256 + wr * 64 + fr, cb = (u.pn & 1) * 256 + wc * 32 + 8 * fq;
        if (kind == 2 && layer == 0) return;
        bf16_t* H = (bf16_t*)((unsigned char*)gin(lds, 29) + OFF_H) + (kind == 0 ? C_LD : (kind == 1 ? C_AA : C_Y));
        const float* bias = kind == 0 ? gin(lds, 7) + layer * 512 : (kind == 1 ? gin(lds, 9) + layer * 512 : gin(lds, 5));
#pragma unroll
        for (int bj = 0; bj < 2; ++bj) { const int c = cb + bj * 128;
            float bias8[8]; ld8f(bias + c, bias8);
#pragma unroll
            for (int ai = 0; ai < 2; ++ai)
#pragma unroll
                for (int m = 0; m < 4; ++m) { const int row = row0 + ai * 128 + m * 16;
                    const f32x4 v0_ = acc[ai][bj][m][0], v1_ = acc[ai][bj][m][1];
                    const float a8[8] = {v0_[0], v0_[1], v0_[2], v0_[3], v1_[0], v1_[1], v1_[2], v1_[3]};
                    float o[8];
                    if (kind == 0) {
#pragma unroll
                        for (int e = 0; e < 8; ++e) { const float uu = bias8[e] + a8[e]; const float wl = -__logf(1.0f + __expf(-uu)) - 0.5f; o[e] = -__expf(wl); }
                    } else {
#pragma unroll
                        for (int e = 0; e < 8; ++e) o[e] = sigmoidf_(bias8[e] + a8[e]);
                    }
                    *(u32x4*)(H + (size_t)row * HP + c) = pack8(o); } }
    }
};
struct EpiMerge {
    static constexpr bool PERM = true, AFTER_DRAIN = false;
    LAS unsigned char* lds; int gcol; int accum;
    __device__ __forceinline__ void operator()(const f32x4 (&acc)[2][2][4][2], const pg8::Unit& u, int wr, int wc, int fr, int fq) const {
        asm volatile("" : "+v"(fr), "+v"(fq), "+s"(wr), "+s"(wc));
        const int row0 = u.pm * 256 + wr * 64 + fr, cb = u.pn * 256 + wc * 32 + 8 * fq;
        unsigned char* wsb = (unsigned char*)gin(lds, 29); const bf16_t* H = (const bf16_t*)(wsb + OFF_H); bf16_t* MIX = (bf16_t*)(wsb + OFF_XB);
#pragma unroll
        for (int ai = 0; ai < 2; ++ai)
#pragma unroll
            for (int m = 0; m < 4; ++m) { const int row = row0 + ai * 128 + m * 16;
#pragma unroll
                for (int bj = 0; bj < 2; ++bj) { const int c = cb + bj * 128;
                    float gt[8], o[8]; unpack8(ldg16(H + (size_t)row * HP + gcol + c), gt);
                    const f32x4 v0_ = acc[ai][bj][m][0], v1_ = acc[ai][bj][m][1];
                    const float a8[8] = {v0_[0], v0_[1], v0_[2], v0_[3], v1_[0], v1_[1], v1_[2], v1_[3]};
#pragma unroll
                    for (int e = 0; e < 8; ++e) o[e] = sigmoidf_(gt[e]) * a8[e];
                    bf16_t* mp = MIX + (size_t)row * 1024 + c;
                    if (accum) { float pv[8]; unpack8(ldg16(mp), pv);
#pragma unroll
                        for (int e = 0; e < 8; ++e) o[e] += pv[e]; }
                    *(u32x4*)mp = pack8(o); } }
    }
};
struct EpiResid {
    static constexpr bool PERM = false, AFTER_DRAIN = false;
    LAS unsigned char* lds; int xin;
    __device__ __forceinline__ void operator()(const f32x4 (&acc)[2][2][4][2], const pg8::Unit& u, int wr, int wc, int fr, int fq) const {
        asm volatile("" : "+v"(fr), "+v"(fq), "+s"(wr), "+s"(wc));
        const int row0 = u.pm * 256 + wr * 64 + fr, col0 = u.pn * 256 + wc * 32 + 4 * fq;
        float* out = (float*)gin(lds, 28); const float* xres = xin ? gin(lds, 0) : (const float*)out;
#pragma unroll
        for (int ai = 0; ai < 2; ++ai)
#pragma unroll
            for (int m = 0; m < 4; ++m) { const size_t off = (size_t)(row0 + ai * 128 + m * 16) * DM + col0;
#pragma unroll
                for (int bj = 0; bj < 2; ++bj)
#pragma unroll
                    for (int n = 0; n < 2; ++n) { const f32x4 x = *(const f32x4*)(xres + off + bj * 128 + n * 16); *(f32x4*)(out + off + bj * 128 + n * 16) = x * ALPHA + acc[ai][bj][m][n]; } }
    }
};

template <class Epi> __device__ __forceinline__ void run_gemm(LAS unsigned char* lds, const bf16_t* A, int lda, const bf16_t* Bt, int N, int K, const Epi& E) {
    asm volatile("" : "+s"(K), "+s"(N), "+s"(lda));
    pg8::Gemm g{A, Bt, TT, N, K, lda}; pg8::StaticOrder S; S.init(TT, N, (int)gridDim.x, obid());
    pg8::gemm_phase<Epi, pg8::StaticOrder, true, true>(lds, g, S, E);
}

__device__ __forceinline__ void tr_block(const float* W, int N, int k0, int n0, bf16_t* WT, int ldk, int drow0, LAS float* scr, int lane) {
#pragma unroll 8
    for (int i = 0; i < 32; ++i) { const int kk = 2 * i + (lane >> 5); scr[kk * 33 + (lane & 31)] = W[(size_t)(k0 + kk) * N + n0 + (lane & 31)]; }
    asm volatile("s_waitcnt lgkmcnt(0)" ::: "memory");
    const int c = lane & 7;
#pragma unroll
    for (int j = 0; j < 4; ++j) { const int n = (lane >> 3) + 8 * j; const LAS float* s = scr + (8 * c) * 33 + n;
        u32x4 o; o.x = cvt_pk_bf16(s[0 * 33], s[1 * 33]); o.y = cvt_pk_bf16(s[2 * 33], s[3 * 33]); o.z = cvt_pk_bf16(s[4 * 33], s[5 * 33]); o.w = cvt_pk_bf16(s[6 * 33], s[7 * 33]);
        *(u32x4*)(WT + (size_t)(drow0 + n) * ldk + k0 + 8 * c) = o; }
    asm volatile("s_waitcnt lgkmcnt(0)" ::: "memory");
}
__device__ __forceinline__ bool tr_seg(int& it, const float* W, int K, int N, bf16_t* WT, int drow_base, LAS float* scr, int lane) {
    const int nblk = N / 32, items = (K / 64) * nblk;
    if (it < items) { const int kb = it / nblk, nb = it % nblk; tr_block(W, N, kb * 64, nb * 32, WT, K, drow_base + nb * 32, scr, lane); return true; }
    it -= items; return false;
}
__device__ __forceinline__ const float* gin(LAS unsigned char* lds, int i);
__device__ __forceinline__ void weights_phase(LAS unsigned char* lds, int l) {
    unsigned char* wsb = (unsigned char*)gin(lds, 29);
    const int tid = otid(), lane = tid & 63, wave = tid >> 6;
    LAS float* scr = (LAS float*)(lds + wave * 8704);
    bf16_t* WB = (bf16_t*)(wsb + OFF_W);
    const int gw = obid() * 8 + wave, NGW = gridDim.x * 8;
    constexpr int NITEMS = 2960 + 16 + 256 + 256 + 512 + 2816 + 1408;
    for (int it0 = gw; it0 < NITEMS; it0 += NGW) { int it = it0;
        if (tr_seg(it, gin(lds, 1) + (size_t)l * 1024 * 5920, 1024, 5920, WB + W_WIN, 0, scr, lane)) continue;
        if (it < 16) { if (l == 1) tr_block(gin(lds, 3), 32, it * 64, 0, WB + W_WIN, 1024, 5920, scr, lane); continue; } it -= 16;
        if (tr_seg(it, gin(lds, 17) + (size_t)l * 512 * 1024, 512, 1024, WB + W_RETO, 0, scr, lane)) continue;
        if (tr_seg(it, gin(lds, 18) + (size_t)l * 512 * 1024, 512, 1024, WB + W_RWKVO, 0, scr, lane)) continue;
        if (tr_seg(it, gin(lds, 19) + (size_t)l * 1024 * 1024, 1024, 1024, WB + W_WOUT, 0, scr, lane)) continue;
        if (tr_seg(it, gin(lds, 22) + (size_t)l * 1024 * 5632, 1024, 5632, WB + W_WUP, 0, scr, lane)) continue;
        tr_seg(it, gin(lds, 25) + (size_t)l * 2816 * 1024, 2816, 1024, WB + W_WDOWN, 0, scr, lane);
    }
    const int gt = obid() * NTHR + tid, NGT = gridDim.x * NTHR;
    const int nv = 5920 + 32 * l;
    for (int i = gt; i < (6144 - nv) * 1024 / 8; i += NGT) *(u32x4*)(WB + W_WIN + (size_t)nv * 1024 + (size_t)i * 8) = (u32x4){0u, 0u, 0u, 0u};
    const float* w2 = gin(lds, 8) + (size_t)l * 64 * 512; const float* a2 = gin(lds, 10) + (size_t)l * 64 * 512; const float* v2 = gin(lds, 6); const float* g2 = gin(lds, 11) + (size_t)l * 160 * 512;
    for (int i = gt; i < 1536 * 256; i += NGT) { const int n = i >> 8, k = i & 255, kind = n >> 9, c = n & 511; float v = 0.f;
        if (kind == 0) { if (k < 64) v = w2[k * 512 + c]; }
        else if (kind == 1) { if (k >= 64 && k < 128) v = a2[(k - 64) * 512 + c]; }
        else { if (l == 1 && k >= 128 && k < 160) v = v2[(k - 128) * 512 + c]; }
        WB[W_LORA + i] = f2bf1(v); }
    for (int i = gt; i < 512 * 256; i += NGT) { const int n = i >> 8, k = i & 255; WB[W_G2T + i] = f2bf1(k < 160 ? g2[k * 512 + n] : 0.f); }
}
__device__ __forceinline__ void x_phase(const float* x, unsigned char* wsb) {
    const int gt = obid() * NTHR + otid(), NGT = gridDim.x * NTHR;
    bf16_t* XB = (bf16_t*)(wsb + OFF_XB);
    for (int i = gt; i < TT * DM / 8; i += NGT) { float f[8]; ld8f(x + (size_t)i * 8, f); *(u32x4*)(XB + (size_t)i * 8) = pack8(f); }
    unsigned* TAB = (unsigned*)(wsb + OFF_TAB);
    for (int i = gt; i < SEQ * 64; i += NGT) { const int pos = i >> 6, f = i & 63;
        const float inv = powf(10000.0f, -(float)f / 64.0f); const float ang = (float)pos * inv;
        const float c = cosf(ang), s = sinf(ang);
        const unsigned lo = __builtin_bit_cast(unsigned short, (_Float16)c), hi = __builtin_bit_cast(unsigned short, (_Float16)s);
        TAB[i] = lo | (hi << 16); }
}

__device__ __forceinline__ void ln_phase(float* X, const float* g, const float* b, bf16_t* XB) {
    const int tid_ = otid(); const int lane = tid_ & 63, wave = tid_ >> 6;
    const int gw = obid() * 8 + wave, NGW = gridDim.x * 8;
    f32x4 gv[4], bv[4];
#pragma unroll
    for (int j = 0; j < 4; ++j) { gv[j] = *(const f32x4*)(g + 4 * lane + 256 * j); bv[j] = *(const f32x4*)(b + 4 * lane + 256 * j); }
    for (int m = gw; m < TT; m += NGW) {
        f32x4* xr = (f32x4*)(X + (size_t)m * DM) + lane;
        f32x4 v[4]; float s = 0.f;
#pragma unroll
        for (int j = 0; j < 4; ++j) { v[j] = xr[64 * j]; s += (v[j].x + v[j].y) + (v[j].z + v[j].w); }
        const float mean = wave_sum(s) * (1.f / DM); float s2 = 0.f;
#pragma unroll
        for (int j = 0; j < 4; ++j) { v[j] = v[j] - mean; s2 += (v[j].x * v[j].x + v[j].y * v[j].y) + (v[j].z * v[j].z + v[j].w * v[j].w); }
        const float rstd = rsqrtf(wave_sum(s2) * (1.f / DM) + 1e-5f);
#pragma unroll
        for (int j = 0; j < 4; ++j) { const f32x4 o = v[j] * rstd * gv[j] + bv[j]; xr[64 * j] = o;
            if (XB) { unsigned lo = cvt_pk_bf16(o.x, o.y), hi = cvt_pk_bf16(o.z, o.w); *(unsigned long long*)(XB + (size_t)m * DM + 4 * lane + 256 * j) = (unsigned long long)lo | ((unsigned long long)hi << 32); } }
    }
}

__device__ __forceinline__ void act_phase(bf16_t* UP, const float* cw, const float* cb) {
    const int gt = obid() * NTHR + otid(), NGT = gridDim.x * NTHR;
    for (int i = gt; i < TT * (DFF / 8); i += NGT) { const int m = i / (DFF / 8), j = (i % (DFF / 8)) * 8; const int t = m & (SEQ - 1);
        bf16_t* row = UP + (size_t)m * UPP;
        float g0[8], g1[8], g2[8], vv[8], w0[8], w1[8], w2[8], bb[8], o[8];
        unpack8(ldg16(row + j), g0); unpack8(ldg16(row + DFF + j), vv);
        if (t >= 1) unpack8(ldg16(row - UPP + j), g1); else {
#pragma unroll
            for (int e = 0; e < 8; ++e) g1[e] = 0.f; }
        if (t >= 2) unpack8(ldg16(row - 2 * UPP + j), g2); else {
#pragma unroll
            for (int e = 0; e < 8; ++e) g2[e] = 0.f; }
        ld8f(cw + j, w0); ld8f(cw + DFF + j, w1); ld8f(cw + 2 * DFF + j, w2); ld8f(cb + j, bb);
#pragma unroll
        for (int e = 0; e < 8; ++e) { const float cv = w0[e] * g2[e] + w1[e] * g1[e] + w2[e] * g0[e] + bb[e]; o[e] = siluf_(cv) * vv[e]; }
        *(u32x4*)(row + DFF + j) = pack8(o); }
}

__device__ __forceinline__ void la_phase(bf16_t* H, bf16_t* LA, bf16_t* KS, bf16_t* VF, const float* mu, const float* muv, int layer) {
    const int gt = obid() * NTHR + otid(), NGT = gridDim.x * NTHR;
    const int per_tok = layer ? 192 : 256;
    for (int i = gt; i < TT * per_tok; i += NGT) { const int m = i / per_tok, gi = i % per_tok; const int t = m & (SEQ - 1);
        int src = -1, mode = 0; const float* mup = mu; bf16_t* dst;
        if (gi < 64) { const int c = gi * 8; dst = LA + (size_t)m * 512 + c;
            if (c < 64) { src = HRW + 1536 + c; mup = mu + 1536 + c; mode = 1; }
            else if (c < 128) { src = HRW + 1600 + (c - 64); mup = mu + 1600 + (c - 64); }
            else if (c < 160) { if (layer) { src = HVL + (c - 128); mup = muv + (c - 128); } }
            else if (c >= 256 && c < 416) { src = HRW + 1664 + (c - 256); mup = mu + 1664 + (c - 256); mode = 2; }
        } else if (gi < 128) { const int c = (gi - 64) * 8; src = HRW + c; mup = mu + c; dst = H + (size_t)m * HP + C_RS + c; }
        else if (gi < 192) { const int c = (gi - 128) * 8; src = HRW + 512 + c; mup = mu + 512 + c; dst = KS + (size_t)m * 512 + c; }
        else { const int c = (gi - 192) * 8; src = HRW + 1024 + c; mup = mu + 1024 + c; dst = VF + (size_t)m * 512 + c; }
        float o[8];
        if (src < 0) {
#pragma unroll
            for (int e = 0; e < 8; ++e) o[e] = 0.f;
        } else {
            const bf16_t* hr = H + (size_t)m * HP + src; float cur[8], prv[8], m8[8];
            unpack8(ldg16(hr), cur); ld8f(mup, m8);
            if (t > 0) unpack8(ldg16(hr - HP), prv); else {
#pragma unroll
                for (int e = 0; e < 8; ++e) prv[e] = 0.f; }
#pragma unroll
            for (int e = 0; e < 8; ++e) { const float z = cur[e] + m8[e] * (prv[e] - cur[e]); o[e] = mode == 1 ? tanhf(z) : (mode == 2 ? sigmoidf_(z) : z); }
        }
        *(u32x4*)dst = pack8(o); }
}

__device__ __forceinline__ void post_phase(bf16_t* H, const bf16_t* VF, const float* stats, const float* bonus, const float* lnx_g, const float* lnx_b) {
    const int gt = obid() * NTHR + otid(), NGT = gridDim.x * NTHR;
    for (int i = gt; i < TT * 64; i += NGT) { const int m = i >> 6, c = (i & 63) * 8, hd = c >> 6;
        bf16_t* hr = H + (size_t)m * HP;
        float y[8], g[8], v[8], st[8], lg[8], lb[8], o[8];
        unpack8(ldg16(hr + C_Y + c), y); unpack8(ldg16(hr + C_G + c), g); unpack8(ldg16(VF + (size_t)m * 512 + c), v); ld8f(stats + ((size_t)m * 8 + hd) * 8, st); ld8f(lnx_g + c, lg); ld8f(lnx_b + c, lb);
        const float bon = bonus[(size_t)m * 8 + hd];
        const float mean = (st[0] + st[2] + st[4] + st[6]) * (1.0f / 64.0f); const float var = fmaxf((st[1] + st[3] + st[5] + st[7]) * (1.0f / 64.0f) - mean * mean, 0.f);
        const float rstd = rsqrtf(var + 64e-5f);
#pragma unroll
        for (int e = 0; e < 8; ++e) o[e] = ((y[e] - mean) * rstd * lg[e] + lb[e] + bon * v[e]) * g[e];
        *(u32x4*)(hr + C_Y + c) = pack8(o); }
}

__device__ __forceinline__ float tab_cos(unsigned u) { return (float)__builtin_bit_cast(_Float16, (unsigned short)(u & 0xffffu)); }
__device__ __forceinline__ float tab_sin(unsigned u) { return (float)__builtin_bit_cast(_Float16, (unsigned short)(u >> 16)); }
__device__ __forceinline__ void rot_pair(const u32x4 lo_raw, const u32x4 hi_raw, const u32x4 t0, const u32x4 t1, float scale, float (&lo)[8], float (&hi)[8]) {
    float a[8], b[8]; unpack8(lo_raw, a); unpack8(hi_raw, b);
    const unsigned tb[8] = {t0.x, t0.y, t0.z, t0.w, t1.x, t1.y, t1.z, t1.w};
#pragma unroll
    for (int e = 0; e < 8; ++e) { const float c = tab_cos(tb[e]), s = tab_sin(tb[e]); lo[e] = (a[e] * c - b[e] * s) * scale; hi[e] = (a[e] * s + b[e] * c) * scale; }
}
__device__ __forceinline__ void ret_state_phase(const bf16_t* H, bf16_t* RB, const unsigned* TAB, LAS unsigned char* lds) {
    const int tid = otid(), lane = tid & 63, wave = tid >> 6, fr = lane & 15, fq = lane >> 4;
    LAS bf16_t* KT = (LAS bf16_t*)lds;
    LAS bf16_t* VT = (LAS bf16_t*)(lds + 2 * 128 * 72 * 2);
    for (int u = obid(); u < 256; u += gridDim.x) {
        const int b = u >> 5, hh = (u >> 3) & 3, es = u & 7;
        const float log_g = __logf(1.0f - exp2f(-5.0f - (float)hh)); const float cdec = __expf(log_g * 64.0f);
        const int c = tid >> 3, dg = tid & 7, d0 = dg * 8;
        const float ksc = 0.08838834764831845f * __expf(log_g * (float)(63 - c));
        const bf16_t* kbase = H + (size_t)(b * SEQ + c) * HP + HK + hh * 128 + d0;
        const bf16_t* vbase = H + (size_t)(b * SEQ + (tid >> 1)) * HP + HV + hh * 128 + es * 16 + (tid & 1) * 8;
        const unsigned* tbase = TAB + (size_t)c * 64 + d0;
        u32x4 k_lo, k_hi, t0, t1, vr = (u32x4){0u, 0u, 0u, 0u};
        k_lo = ldg16(kbase); k_hi = ldg16(kbase + 64); t0 = ldg16(tbase); t1 = ldg16(tbase + 4); if (tid < 128) vr = ldg16(vbase);
        f32x4 acc = (f32x4){0.f, 0.f, 0.f, 0.f};
        bf16_t* rout = RB + ((size_t)((b * 4 + hh) * 64) * 128 + es * 16 + fr) * 128 + wave * 16 + 4 * fq;
        for (int n = 0; n < 64; ++n) {
            const int buf = n & 1; LAS bf16_t* kt = KT + buf * 128 * 72; LAS bf16_t* vt = VT + buf * 16 * 72;
            { float lo[8], hi[8]; rot_pair(k_lo, k_hi, t0, t1, ksc, lo, hi);
#pragma unroll
              for (int e = 0; e < 8; ++e) { kt[(d0 + e) * 72 + c] = f2bf1(lo[e]); kt[(64 + d0 + e) * 72 + c] = f2bf1(hi[e]); } }
            if (tid < 128) { const unsigned w4[4] = {vr.x, vr.y, vr.z, vr.w}; const int cc = tid >> 1, e0 = (tid & 1) * 8;
#pragma unroll
                for (int e = 0; e < 4; ++e) { vt[(e0 + 2 * e) * 72 + cc] = (bf16_t)(w4[e] & 0xffffu); vt[(e0 + 2 * e + 1) * 72 + cc] = (bf16_t)(w4[e] >> 16); } }
            if (n + 1 < 64) { const size_t adv = (size_t)(n + 1) * 64 * HP; k_lo = ldg16(kbase + adv); k_hi = ldg16(kbase + adv + 64); t0 = ldg16(tbase + (size_t)(n + 1) * 64 * 64); t1 = ldg16(tbase + (size_t)(n + 1) * 64 * 64 + 4); if (tid < 128) vr = ldg16(vbase + adv); }
            __syncthreads();
            { unsigned lo = cvt_pk_bf16(acc[0], acc[1]), hi = cvt_pk_bf16(acc[2], acc[3]); *(unsigned long long*)(rout + (size_t)n * 128 * 128) = (unsigned long long)lo | ((unsigned long long)hi << 32); }
            acc = acc * cdec;
#pragma unroll
            for (int ks = 0; ks < 2; ++ks) { const bf16x8 a = *(const LAS bf16x8*)(kt + (wave * 16 + fr) * 72 + ks * 32 + fq * 8); const bf16x8 bb = *(const LAS bf16x8*)(vt + fr * 72 + ks * 32 + fq * 8);
                acc = __builtin_amdgcn_mfma_f32_16x16x32_bf16(a, bb, acc, 0, 0, 0); }
        }
        __syncthreads();
    }
}
__device__ __forceinline__ void ret_out_phase(bf16_t* H, const bf16_t* RB, const unsigned* TAB, LAS unsigned char* lds) {
    const int tid = otid(), lane = tid & 63, wave = tid >> 6, fr = lane & 15, fq = lane >> 4;
    LAS bf16_t* Qs = (LAS bf16_t*)lds;
    LAS bf16_t* Ks = (LAS bf16_t*)(lds + 17408);
    LAS bf16_t* VT = (LAS bf16_t*)(lds + 34816);
    LAS bf16_t* Ps = (LAS bf16_t*)(lds + 34816 + 18432);
    LAS float* SS = (LAS float*)(lds + 34816 + 18432 + 9216);
    for (int u = obid(); u < 2048; u += gridDim.x) {
        const int n = u & 63, hh = (u >> 6) & 3, b = u >> 8;
        const float log_g = __logf(1.0f - exp2f(-5.0f - (float)hh));
        __syncthreads();
        {
            const int c = tid >> 3, dg = tid & 7, d0 = dg * 8; const size_t m = (size_t)b * SEQ + n * 64 + c;
            const bf16_t* hr = H + m * HP + hh * 128;
            const unsigned* tb = TAB + (size_t)(n * 64 + c) * 64 + d0; const u32x4 t0 = ldg16(tb), t1 = ldg16(tb + 4);
            float lo[8], hi[8];
            rot_pair(ldg16(hr + HQ + d0), ldg16(hr + HQ + 64 + d0), t0, t1, 1.0f, lo, hi);
            *(LAS u32x4*)(Qs + c * 136 + d0) = pack8(lo); *(LAS u32x4*)(Qs + c * 136 + 64 + d0) = pack8(hi);
            rot_pair(ldg16(hr + HK + d0), ldg16(hr + HK + 64 + d0), t0, t1, 0.08838834764831845f, lo, hi);
            *(LAS u32x4*)(Ks + c * 136 + d0) = pack8(lo); *(LAS u32x4*)(Ks + c * 136 + 64 + d0) = pack8(hi);
            const u32x4 v0 = ldg16(hr + HV + dg * 16), v1 = ldg16(hr + HV + dg * 16 + 8);
            const unsigned w8[8] = {v0.x, v0.y, v0.z, v0.w, v1.x, v1.y, v1.z, v1.w};
#pragma unroll
            for (int e = 0; e < 8; ++e) { VT[(dg * 16 + 2 * e) * 72 + c] = (bf16_t)(w8[e] & 0xffffu); VT[(dg * 16 + 2 * e + 1) * 72 + c] = (bf16_t)(w8[e] >> 16); }
        }
        bf16x8 rx[4];
        { const bf16_t* rb = RB + ((size_t)((b * 4 + hh) * 64 + n) * 128 + wave * 16 + fr) * 128 + fq * 8;
#pragma unroll
          for (int ks = 0; ks < 4; ++ks) rx[ks] = *(const bf16x8*)(rb + ks * 32); }
        __syncthreads();
        { const int mb = wave & 3, nb0 = 2 * (wave >> 2);
          f32x4 s0 = (f32x4){0.f, 0.f, 0.f, 0.f}, s1 = s0;
#pragma unroll
          for (int ks = 0; ks < 4; ++ks) { const bf16x8 a = *(const LAS bf16x8*)(Qs + (mb * 16 + fr) * 136 + ks * 32 + fq * 8);
              const bf16x8 b0 = *(const LAS bf16x8*)(Ks + (nb0 * 16 + fr) * 136 + ks * 32 + fq * 8), b1 = *(const LAS bf16x8*)(Ks + ((nb0 + 1) * 16 + fr) * 136 + ks * 32 + fq * 8);
              s0 = __builtin_amdgcn_mfma_f32_16x16x32_bf16(a, b0, s0, 0, 0, 0); s1 = __builtin_amdgcn_mfma_f32_16x16x32_bf16(a, b1, s1, 0, 0, 0); }
#pragma unroll
          for (int r = 0; r < 4; ++r) { const int cc = mb * 16 + 4 * fq + r; const int sA = nb0 * 16 + fr, sB = sA + 16;
              const float dA = __expf(log_g * fabsf((float)(cc - sA))), dB = __expf(log_g * fabsf((float)(cc - sB)));
              Ps[cc * 72 + sA] = f2bf1(s0[r] * dA); Ps[cc * 72 + sB] = f2bf1(s1[r] * dB); } }
        f32x4 o[4];
#pragma unroll
        for (int mb = 0; mb < 4; ++mb) { o[mb] = (f32x4){0.f, 0.f, 0.f, 0.f};
#pragma unroll
            for (int ks = 0; ks < 4; ++ks) { const bf16x8 a = *(const LAS bf16x8*)(Qs + (mb * 16 + fr) * 136 + ks * 32 + fq * 8); o[mb] = __builtin_amdgcn_mfma_f32_16x16x32_bf16(a, rx[ks], o[mb], 0, 0, 0); }
#pragma unroll
            for (int r = 0; r < 4; ++r) o[mb][r] *= __expf(log_g * (float)(mb * 16 + 4 * fq + r + 1)); }
        __syncthreads();
#pragma unroll
        for (int mb = 0; mb < 4; ++mb)
#pragma unroll
            for (int ks = 0; ks < 2; ++ks) { const bf16x8 a = *(const LAS bf16x8*)(Ps + (mb * 16 + fr) * 72 + ks * 32 + fq * 8); const bf16x8 bb = *(const LAS bf16x8*)(VT + (wave * 16 + fr) * 72 + ks * 32 + fq * 8);
                o[mb] = __builtin_amdgcn_mfma_f32_16x16x32_bf16(a, bb, o[mb], 0, 0, 0); }
#pragma unroll
        for (int mb = 0; mb < 4; ++mb)
#pragma unroll
            for (int r = 0; r < 4; ++r) { const float ss = row16_sum(o[mb][r] * o[mb][r]); if (fr == 0) SS[(mb * 16 + 4 * fq + r) * 8 + wave] = ss; }
        __syncthreads();
#pragma unroll
        for (int mb = 0; mb < 4; ++mb)
#pragma unroll
            for (int r = 0; r < 4; ++r) { const int cc = mb * 16 + 4 * fq + r; const f32x4 p0 = *(const LAS f32x4*)(SS + cc * 8), p1 = *(const LAS f32x4*)(SS + cc * 8 + 4);
                const float tot = (p0.x + p0.y) + (p0.z + p0.w) + (p1.x + p1.y) + (p1.z + p1.w); const float rinv = rsqrtf(tot * (1.0f / 128.0f) + 1e-6f);
                bf16_t* hr = H + ((size_t)b * SEQ + n * 64 + cc) * HP + hh * 128 + wave * 16 + fr;
                const float g = bflo((unsigned)hr[HG]);
                hr[C_RETIN] = f2bf1(o[mb][r] * rinv * siluf_(g)); }
    }
    __syncthreads();
}

__device__ __forceinline__ void scan_phase(bf16_t* H, const bf16_t* KS, bf16_t* VF, float* stats, float* bonus, const float* k_k, const float* k_a, const float* r_k, const float* muv, int layer, LAS unsigned char* lds) {
    const int tid = otid(), lane = tid & 63, wave = tid >> 6;
    LAS float* PB = (LAS float*)lds;
    LAS float* VB = (LAS float*)(lds + 81920);
    LAS float* SC = (LAS float*)(lds + 81920 + 4096);
    LAS float* YB = (LAS float*)(lds + 81920 + 4096 + 512);
    for (int u = obid(); u < 256; u += gridDim.x) {
        const int bh = u >> 2, part = u & 3, b = bh >> 3, hd = bh & 7, i0 = part * 16;
        __syncthreads();
        if (wave >= 4) {
            const int hid = tid - 256, t = hid >> 3, jg = hid & 7, col = hd * 64 + jg * 8;
            float kk8[8], ka8[8], rk8[8]; ld8f(k_k + col, kk8); ld8f(k_a + col, ka8); ld8f(r_k + col, rk8);
            for (int c = -1; c <= 128; ++c) {
                if (c >= 1) {
                    const int ob = (c - 1) & 1; const size_t m = (size_t)b * SEQ + (c - 1) * 32 + t;
                    const float y0 = YB[(ob * 32 + t) * 16 + 2 * jg], y1 = YB[(ob * 32 + t) * 16 + 2 * jg + 1];
                    *(unsigned*)(H + m * HP + C_Y + hd * 64 + i0 + 2 * jg) = cvt_pk_bf16(y0, y1);
                    float s = y0 + y1, q = y0 * y0 + y1 * y1;
                    s += __shfl_xor(s, 1); q += __shfl_xor(q, 1); s += __shfl_xor(s, 2); q += __shfl_xor(q, 2); s += __shfl_xor(s, 4); q += __shfl_xor(q, 4);
                    if (jg == 0) { float* sp = stats + ((m * 8 + hd) * 4 + part) * 2; sp[0] = s; sp[1] = q; }
                }
                if (c + 1 < 128) {
                    const int nb = (c + 1) & 1; const size_t m = (size_t)b * SEQ + (c + 1) * 32 + t;
                    const bf16_t* hr = H + m * HP + col;
                    float r8[8], l8[8], a8[8], k8[8];
                    unpack8(ldg16(hr + C_RS), r8); unpack8(ldg16(hr + C_LD), l8); unpack8(ldg16(hr + C_AA), a8); unpack8(ldg16(KS + m * 512 + col), k8);
                    float kkv[8], ssq = 0.f;
#pragma unroll
                    for (int e = 0; e < 8; ++e) { kkv[e] = k8[e] * kk8[e]; ssq += kkv[e] * kkv[e]; }
                    ssq += __shfl_xor(ssq, 1); ssq += __shfl_xor(ssq, 2); ssq += __shfl_xor(ssq, 4);
                    const float inv = 1.0f / fmaxf(sqrtf(ssq), 1e-12f);
                    float na[8], wr[8], w[8], bb[8], kt[8]; float br = 0.f, kr = 0.f, bo = 0.f;
#pragma unroll
                    for (int e = 0; e < 8; ++e) { const float kn = kkv[e] * inv; w[e] = __expf(l8[e]); kt[e] = k8[e] * (1.0f + (a8[e] - 1.0f) * ka8[e]); bb[e] = kn * a8[e]; na[e] = -kn; wr[e] = w[e] * r8[e];
                        br += bb[e] * r8[e]; kr += kt[e] * r8[e]; bo += r8[e] * kt[e] * rk8[e]; }
                    br += __shfl_xor(br, 1); kr += __shfl_xor(kr, 1); bo += __shfl_xor(bo, 1); br += __shfl_xor(br, 2); kr += __shfl_xor(kr, 2); bo += __shfl_xor(bo, 2); br += __shfl_xor(br, 4); kr += __shfl_xor(kr, 4); bo += __shfl_xor(bo, 4);
                    LAS float* pb = PB + ((nb * 32 + t) * 16 + 2 * jg) * 20;
#pragma unroll
                    for (int h2 = 0; h2 < 2; ++h2) { LAS f32x4* q4 = (LAS f32x4*)(pb + h2 * 20);
                        q4[0] = (f32x4){na[4 * h2], na[4 * h2 + 1], na[4 * h2 + 2], na[4 * h2 + 3]}; q4[1] = (f32x4){wr[4 * h2], wr[4 * h2 + 1], wr[4 * h2 + 2], wr[4 * h2 + 3]};
                        q4[2] = (f32x4){w[4 * h2], w[4 * h2 + 1], w[4 * h2 + 2], w[4 * h2 + 3]}; q4[3] = (f32x4){bb[4 * h2], bb[4 * h2 + 1], bb[4 * h2 + 2], bb[4 * h2 + 3]};
                        q4[4] = (f32x4){kt[4 * h2], kt[4 * h2 + 1], kt[4 * h2 + 2], kt[4 * h2 + 3]}; }
                    if (jg < 2) { float v8[8]; const int vc = hd * 64 + i0 + jg * 8; unpack8(ldg16(VF + m * 512 + vc), v8);
                        if (layer) { float cur[8], prv[8], sg[8], m8[8]; const bf16_t* hv = H + m * HP; unpack8(ldg16(hv + HRW + 1024 + vc), cur); unpack8(ldg16(hv + C_Y + vc), sg); ld8f(muv + vc, m8);
                            if ((c + 1) * 32 + t > 0) unpack8(ldg16(hv - HP + HRW + 1024 + vc), prv); else {
#pragma unroll
                                for (int e = 0; e < 8; ++e) prv[e] = 0.f; }
#pragma unroll
                            for (int e = 0; e < 8; ++e) { const float z = cur[e] + m8[e] * (prv[e] - cur[e]); v8[e] = z + (v8[e] - z) * sg[e]; }
                            *(u32x4*)(VF + m * 512 + vc) = pack8(v8); unpack8(pack8(v8), v8); }
                        LAS f32x4* vp = (LAS f32x4*)(VB + (nb * 32 + t) * 16 + jg * 8);
                        vp[0] = (f32x4){v8[0], v8[1], v8[2], v8[3]}; vp[1] = (f32x4){v8[4], v8[5], v8[6], v8[7]}; }
                    if (jg == 0) { SC[(nb * 32 + t) * 2] = br; SC[(nb * 32 + t) * 2 + 1] = kr; if (part == 0) bonus[m * 8 + hd] = bo; }
                }
                if (c < 128) __syncthreads();
            }
        } else {
            const int il = wave * 4 + (lane >> 4), q = lane & 15;
            f32x4 s = (f32x4){0.f, 0.f, 0.f, 0.f};
            __syncthreads();
            for (int c = 0; c < 128; ++c) {
                const int buf = c & 1; const LAS float* pb = PB + (buf * 32 * 16 + q) * 20; const LAS float* vb = VB + buf * 32 * 16 + il; const LAS float* sc = SC + buf * 64; LAS float* yb = YB + buf * 32 * 16 + il;
                struct Stp { f32x4 na, wr, w, bb, kt; float vi, br, kr; };
#define LDSTEP(S, tt) { const LAS f32x4* p4 = (const LAS f32x4*)(pb + (tt) * 320); S.na = p4[0]; S.wr = p4[1]; S.w = p4[2]; S.bb = p4[3]; S.kt = p4[4]; S.vi = vb[(tt) * 16]; \
                        const pg8::f32x2 s2_ = *(const LAS pg8::f32x2*)(sc + 2 * (tt)); S.br = s2_.x; S.kr = s2_.y; }
                Stp cur; LDSTEP(cur, 0);
#pragma unroll
                for (int t = 0; t < 32; ++t) {
                    Stp nxt; if (t + 1 < 32) LDSTEP(nxt, t + 1) else nxt = cur;
                    float pa = (s.x * cur.na.x + s.y * cur.na.y) + (s.z * cur.na.z + s.w * cur.na.w);
                    float py = (s.x * cur.wr.x + s.y * cur.wr.y) + (s.z * cur.wr.z + s.w * cur.wr.w);
                    const f32x4 uu = cur.kt * cur.vi; const float vk = cur.vi * cur.kr;
                    const float sa = row16_sum(pa), sy = row16_sum(py);
                    s = s * cur.w + (cur.bb * sa + uu);
                    if (q == 0) yb[t * 16] = sy + sa * cur.br + vk;
                    cur = nxt;
                }
#undef LDSTEP
                __syncthreads();
            }
        }
    }
    __syncthreads();
}

#define XB_TMO      128
#define XB_XCNT(j)  (256  + 64 * (j))
#define XB_XSUB(j)  (1280 + 64 * (j))
#define XB_XGEN(j)  (2304 + 64 * (j))
#define XB_TOP      3328
#define XB_TOPGEN   3392
#define XCD_BAR_WORDS 3456
#define XB_SPIN_CAP (1u << 18)

__device__ __forceinline__ unsigned xb_ld(unsigned* p)              { return __hip_atomic_load(p, __ATOMIC_RELAXED, __HIP_MEMORY_SCOPE_AGENT); }
__device__ __forceinline__ unsigned xb_add(unsigned* p, unsigned v) { return __hip_atomic_fetch_add(p, v, __ATOMIC_RELAXED, __HIP_MEMORY_SCOPE_AGENT); }
__device__ __forceinline__ unsigned xb_xcc_id() { return (unsigned)__builtin_amdgcn_s_getreg((3 << 11) | 20) & 0xFu; }
#define XB_SPIN(cond, bar) do { unsigned _sp = 0; while (cond) { __builtin_amdgcn_s_sleep(1); \
    if ((++_sp & 255u) == 0u) { if (xb_ld(&(bar)[XB_TMO])) break; if (_sp > XB_SPIN_CAP) { atomicAdd(&(bar)[XB_TMO], 1u); break; } } } } while (0)

struct XcdBarrier {
    unsigned* bar; unsigned x;
    volatile LAS unsigned* st;
};

__device__ __forceinline__ XcdBarrier xcd_barrier_post(unsigned* bar, volatile LAS unsigned* st) {
    XcdBarrier b; b.bar = bar; b.x = xb_xcc_id(); b.st = st;
    if (threadIdx.x == 0) (void)xb_add(&bar[XB_XCNT(b.x)], 1u);
    return b;
}
__device__ __forceinline__ void xcd_barrier_complete(unsigned* bar, unsigned x, unsigned& nloc, unsigned& nx) {
    const unsigned G = gridDim.x * gridDim.y * gridDim.z;
    unsigned sum, cnt, mine, sp = 0u;
    for (;;) {
        sum = 0u; cnt = 0u; mine = 0u;
#pragma unroll
        for (unsigned j = 0; j < 16; ++j) { const unsigned c = xb_ld(&bar[XB_XCNT(j)]); sum += c; cnt += (c > 0u) ? 1u : 0u; mine = (j == x) ? c : mine; }
        if (sum == G) break;
        __builtin_amdgcn_s_sleep(1);
        if ((++sp & 255u) == 0u) { if (xb_ld(&bar[XB_TMO])) break; if (sp > XB_SPIN_CAP) { atomicAdd(&bar[XB_TMO], 1u); break; } }
    }
    nloc = mine > 0u ? mine : 1u; nx = cnt > 0u ? cnt : 1u;
}

__device__ __forceinline__ void xcd_barrier(const XcdBarrier& b) {
    asm volatile("s_waitcnt vmcnt(0)" ::: "memory");
    __syncthreads();
    if (threadIdx.x == 0) {
        unsigned* bar = b.bar;
        __builtin_amdgcn_s_waitcnt(0);
        unsigned nloc = b.st[0], nx = b.st[1];
        if (nloc == 0u) { xcd_barrier_complete(bar, b.x, nloc, nx); b.st[0] = nloc; b.st[1] = nx; }
        const unsigned old = xb_add(&bar[XB_XSUB(b.x)], 1u);
        const unsigned gen = old / nloc;
        if (old + 1u == (gen + 1u) * nloc) {
            __builtin_amdgcn_fence(__ATOMIC_RELEASE, "agent");
            asm volatile("s_waitcnt vmcnt(0)" ::: "memory");
            const unsigned og = xb_add(&bar[XB_TOP], 1u);
            const unsigned tg = og / nx;
            if (og + 1u == (tg + 1u) * nx) xb_add(&bar[XB_TOPGEN], 1u);
            else XB_SPIN(xb_ld(&bar[XB_TOPGEN]) == tg, bar);
            __builtin_amdgcn_fence(__ATOMIC_ACQUIRE, "agent");
            xb_add(&bar[XB_XGEN(b.x)], 1u);
            asm volatile("s_waitcnt vmcnt(0)" ::: "memory");
        } else {
            XB_SPIN(xb_ld(&bar[XB_XGEN(b.x)]) == gen, bar);
            __builtin_amdgcn_fence(__ATOMIC_ACQUIRE, "agent");
            asm volatile("s_waitcnt vmcnt(0)" ::: "memory");
        }
    }
    __syncthreads();
}

constexpr int PT_OFF = 131072;
__device__ __forceinline__ const float* gin(LAS unsigned char* lds, int i) { const unsigned long long v = ((volatile LAS unsigned long long*)(lds + PT_OFF))[i];
    const unsigned lo = __builtin_amdgcn_readfirstlane((unsigned)v), hi = __builtin_amdgcn_readfirstlane((unsigned)(v >> 32)); return (const float*)(((unsigned long long)hi << 32) | lo); }
__global__ void __launch_bounds__(NTHR) mega_fwd(Params p) {
    extern __shared__ __attribute__((aligned(16))) unsigned char lds_raw[];
    LAS unsigned char* lds = (LAS unsigned char*)lds_raw;
    cg::grid_group grid = cg::this_grid();
    if (threadIdx.x == 0) { volatile LAS unsigned long long* PT = (volatile LAS unsigned long long*)(lds + PT_OFF);
#pragma unroll
        for (int i = 0; i < 28; ++i) PT[i] = (unsigned long long)p.in[i];
        PT[28] = (unsigned long long)p.out; PT[29] = (unsigned long long)p.ws;
        ((volatile LAS unsigned*)(lds + PT_OFF + 512))[0] = 0u; ((volatile LAS unsigned*)(lds + PT_OFF + 512))[1] = 0u; }
    __syncthreads();
    (void)xcd_barrier_post((unsigned*)p.ws, (volatile LAS unsigned*)(lds + PT_OFF + 512));
#define OL ({ LAS unsigned char* q_ = lds; asm volatile("" : "+s"(q_)); q_; })
#define GSYNC() do { XcdBarrier b_; b_.bar = (unsigned*)gin(OL, 29); b_.x = xb_xcc_id(); b_.st = (volatile LAS unsigned*)(OL + PT_OFF + 512); xcd_barrier(b_); } while (0)
#define WSP ((unsigned char*)gin(OL, 29))
#define OUTP ((float*)gin(OL, 28))
#define P_TAB ((unsigned*)(WSP + OFF_TAB))
#define P_BONUS ((float*)(WSP + OFF_BONUS))
#define P_STATS ((float*)(WSP + OFF_STATS))
#define P_WB ((bf16_t*)(WSP + OFF_W))
#define P_VF ((bf16_t*)(WSP + OFF_VF))
#define P_XB ((bf16_t*)(WSP + OFF_XB))
#define P_H ((bf16_t*)(WSP + OFF_H))
#define P_KS (P_XB + (size_t)TT * 512)


#ifndef NO_W
        weights_phase(OL, 0);
#endif

#ifndef NO_X
        x_phase(gin(OL, 0), WSP);
#endif

    grid.sync();
#pragma unroll 1
    for (int l = 0; l < 2; ++l) {

#ifndef NO_G1
        { EpiStore E{OL, HP, 5920 + 32 * l, 0}; run_gemm(OL, P_XB, 1024, P_WB + W_WIN, 6144, 1024, E); }
#ifdef DBL_G1
        { GSYNC(); { EpiStore E{OL, HP, 5920 + 32 * l, 0}; run_gemm(OL, P_XB, 1024, P_WB + W_WIN, 6144, 1024, E); } }
#endif

#endif

        GSYNC();

#ifndef NO_RS
        ret_state_phase(P_H, P_XB, P_TAB, OL);
#ifdef DBL_RS
        { GSYNC(); ret_state_phase(P_H, P_XB, P_TAB, OL); }
#endif

#endif

        GSYNC();

#ifndef NO_RO
        ret_out_phase(P_H, P_XB, P_TAB, OL);
#endif

        GSYNC();

#ifndef NO_LA
        la_phase(P_H, P_XB, P_KS, P_VF, gin(OL, 2) + l * 1824, gin(OL, 4), l);
#ifdef DBL_LA
        { GSYNC(); la_phase(P_H, P_XB, P_KS, P_VF, gin(OL, 2) + l * 1824, gin(OL, 4), l); }
#endif

#endif

        GSYNC();

#ifndef NO_G5
        { EpiLora E{OL, l}; run_gemm(OL, P_XB, 512, P_WB + W_LORA, 1536, 256, E); }
#endif

#ifndef NO_G7
        { EpiStore E{OL, HP, 512, C_G}; run_gemm(OL, P_XB + 256, 512, P_WB + W_G2T, 512, 256, E); }
#endif

        GSYNC();

#ifndef NO_SCAN
        scan_phase(P_H, P_KS, P_VF, P_STATS, P_BONUS, gin(OL, 12) + l * 512, gin(OL, 13) + l * 512, gin(OL, 14) + l * 512, gin(OL, 2) + l * 1824 + 1024, l, OL);
#ifdef DBL_SCAN
        if (l == 0) { GSYNC(); scan_phase(P_H, P_KS, P_VF, P_STATS, P_BONUS, gin(OL, 12) + l * 512, gin(OL, 13) + l * 512, gin(OL, 14) + l * 512, gin(OL, 2) + l * 1824 + 1024, l, OL); }
#endif

#endif

        GSYNC();

#ifndef NO_POST
        post_phase(P_H, P_VF, P_STATS, P_BONUS, gin(OL, 15) + l * 512, gin(OL, 16) + l * 512);
#endif

        GSYNC();

#ifndef NO_G8
        { EpiMerge E{OL, HGA, 0}; run_gemm(OL, P_H + C_RETIN, HP, P_WB + W_RETO, 1024, 512, E); }
#endif


#ifndef NO_G9
        { EpiMerge E{OL, HGB, 1}; run_gemm(OL, P_H + C_Y, HP, P_WB + W_RWKVO, 1024, 512, E); }
#endif

        GSYNC();

#ifndef NO_G10
        { EpiResid E{OL, l == 0 ? 1 : 0}; run_gemm(OL, P_XB, 1024, P_WB + W_WOUT, 1024, 1024, E); }
#endif

        GSYNC();

#ifndef NO_LN1
        ln_phase(OUTP, gin(OL, 20) + l * 1024, gin(OL, 21) + l * 1024, P_XB);
#endif

        GSYNC();

#ifndef NO_G12
        { EpiStore E{OL, UPP, UPP, 0}; run_gemm(OL, P_XB, 1024, P_WB + W_WUP, UPP, 1024, E); }
#ifdef DBL_G12
        { GSYNC(); { EpiStore E{OL, UPP, UPP, 0}; run_gemm(OL, P_XB, 1024, P_WB + W_WUP, UPP, 1024, E); } }
#endif

#endif

        GSYNC();

#ifndef NO_ACT
        act_phase(P_H, gin(OL, 23) + (size_t)l * 3 * DFF, gin(OL, 24) + (size_t)l * DFF);
#endif

        GSYNC();

#ifndef NO_G14
        { EpiResid E{OL, 0}; run_gemm(OL, P_H + DFF, UPP, P_WB + W_WDOWN, 1024, DFF, E); }
#endif

        GSYNC();

#ifndef NO_LN2
        ln_phase(OUTP, gin(OL, 26) + l * 1024, gin(OL, 27) + l * 1024, l == 0 ? P_XB : (bf16_t*)nullptr);
#endif

        if (l == 0) {
#ifndef NO_W1
        weights_phase(OL, 1);
#ifdef DBL_W
        { GSYNC(); weights_phase(OL, 1); }
#endif

#endif
 GSYNC(); }
#ifdef DBL_SYNC
        for (int zz = 0; zz < 20; ++zz) GSYNC();
#endif
    }
}

extern "C" void kernel_launch(void* const* d_in, const int* in_sizes, int n_in, void* d_out, int out_size, void* d_ws, size_t ws_size, hipStream_t stream) {
    static int grid = 0;
    if (grid == 0) {
        if (n_in != 28 || ws_size < WS_END) { fprintf(stderr, "kernel_launch: unexpected n_in %d or ws_size %zu (need %zu)\n", n_in, ws_size, (size_t)WS_END); grid = -1; return; }
        int dev = 0, cus = 0, per_cu = 0;
        hipGetDevice(&dev); hipDeviceGetAttribute(&cus, hipDeviceAttributeMultiprocessorCount, dev);
        hipFuncSetAttribute((const void*)mega_fwd, hipFuncAttributeMaxDynamicSharedMemorySize, LDS_BYTES);
        hipOccupancyMaxActiveBlocksPerMultiprocessor(&per_cu, (const void*)mega_fwd, NTHR, LDS_BYTES);
        if (per_cu < 1) { fprintf(stderr, "kernel_launch: occupancy query says %d blocks/CU\n", per_cu); grid = -1; return; }
        grid = cus;
    }
    if (grid < 0) return;
    if (hipMemsetAsync(d_ws, 0, 16384, stream) != hipSuccess) { fprintf(stderr, "memset failed\n"); return; }
    Params p{};
    for (int i = 0; i < 28; ++i) p.in[i] = (const float*)d_in[i];
    p.out = (float*)d_out; p.ws = (unsigned char*)d_ws;
    void* args[] = {&p};
    hipError_t e = hipLaunchCooperativeKernel((const void*)mega_fwd, dim3(grid), dim3(NTHR), args, LDS_BYTES, stream);
    if (e != hipSuccess) fprintf(stderr, "cooperative launch failed: %s (grid %d)\n", hipGetErrorString(e), grid);
}
```
